# Optimizing an MI355X kernel written in HIP

```python
import numpy as np
import jax, jax.numpy as jnp
from jax import lax

D_MODEL = 2048
BATCH = 4
SEQ = 8192
DEPTH = 4

CTX_LEN = 256
GRID_W = 64
MIX_WIDTH = D_MODEL
NA_WIDTH = D_MODEL // 2
NA_HEADS = 8
NA_HEAD_DIM = NA_WIDTH // NA_HEADS
CONV_WIDTH = MIX_WIDTH - NA_WIDTH
CONV_K = 3
WIN_R = 8
WIN_C = 16
D_FF = 4 * D_MODEL
N_MOD = 6
IN_SPLITS = tuple(int(s) for s in np.cumsum([NA_WIDTH, NA_WIDTH, NA_WIDTH, CONV_WIDTH, CONV_WIDTH]))
IN_COLS = 3 * NA_WIDTH + 3 * CONV_WIDTH
EPS = 1e-6

kernel_name = "hymba_natten_shortconv_dit_block"


def rms_norm(x, g):
    xf = x.astype(jnp.float32)
    y = xf * lax.rsqrt(jnp.mean(xf * xf, axis=-1, keepdims=True) + EPS)
    return (y * g.astype(jnp.float32)).astype(x.dtype)


def modulate(h, shift, scale):
    return h * (1 + scale) + shift


def to_heads(t):
    b, l, _ = t.shape
    return t.reshape(b, l, NA_HEADS, NA_HEAD_DIM).transpose(0, 2, 1, 3)


def from_heads(t):
    b, h, l, d = t.shape
    return t.transpose(0, 2, 1, 3).reshape(b, l, h * d)


def short_conv(u, w):
    l = u.shape[1]
    half = CONV_K // 2
    up = jnp.pad(u, ((0, 0), (half, half), (0, 0)))
    return sum(up[:, k:k + l] * w[k] for k in range(CONV_K))


def conv_mixer(b_gate, c_gate, v, w):
    return b_gate * short_conv(c_gate * v, w)


def context_attention(q, k, v):
    s = jnp.einsum('bhqd,bhkd->bhqk', q, k).astype(jnp.float32) * (NA_HEAD_DIM ** -0.5)
    p = jax.nn.softmax(s, axis=-1).astype(v.dtype)
    return jnp.einsum('bhqk,bhkd->bhqd', p, v)


def neighbourhood_attention(q, k, v, k_ctx, v_ctx, rpb):
    b, h, s, dh = q.shape
    rows = s // GRID_W
    kr = min(WIN_R, rows)
    kc = WIN_C
    kg = k.reshape(b, h, rows, GRID_W, dh)
    vg = v.reshape(b, h, rows, GRID_W, dh)
    q_rows = q.reshape(b, h, rows, GRID_W, dh).transpose(2, 0, 1, 3, 4)
    col = np.arange(GRID_W)
    col_start = np.clip(col - kc // 2, 0, GRID_W - kc)
    col_idx = col_start[:, None] + np.arange(kc)[None, :]
    dc = col_idx - col[:, None] + (WIN_C - 1)
    scale = NA_HEAD_DIM ** -0.5
    n_loc = kr * kc

    def one_row(args):
        r, q_r = args
        rs = jnp.clip(r - kr // 2, 0, rows - kr)
        k_rows = lax.dynamic_slice_in_dim(kg, rs, kr, axis=2)
        v_rows = lax.dynamic_slice_in_dim(vg, rs, kr, axis=2)
        k_win = k_rows[:, :, :, col_idx]
        v_win = v_rows[:, :, :, col_idx]
        s_loc = jnp.einsum('bhqd,bhaqcd->bhqac', q_r, k_win).astype(jnp.float32) * scale
        dr = rs + jnp.arange(kr) - r + (WIN_R - 1)
        bias = rpb[:, dr[:, None, None], dc[None, :, :]]
        s_loc = s_loc + bias.transpose(0, 2, 1, 3)[None].astype(jnp.float32)
        s_ctx = jnp.einsum('bhqd,bhkd->bhqk', q_r, k_ctx).astype(jnp.float32) * scale
        sc = jnp.concatenate([s_loc.reshape(b, h, GRID_W, n_loc), s_ctx], axis=-1)
        p = jax.nn.softmax(sc, axis=-1).astype(v.dtype)
        p_loc = p[..., :n_loc].reshape(b, h, GRID_W, kr, kc)
        p_ctx = p[..., n_loc:]
        return (jnp.einsum('bhqac,bhaqcd->bhqd', p_loc, v_win)
                + jnp.einsum('bhqk,bhkd->bhqd', p_ctx, v_ctx))

    out = lax.map(one_row, (jnp.arange(rows), q_rows))
    return out.transpose(1, 2, 0, 3, 4).reshape(b, h, s, dh)


def merge_and_project(o_na, o_conv, g_na, g_conv, w_o):
    mixed = jnp.concatenate([rms_norm(o_na, g_na), rms_norm(o_conv, g_conv)], axis=-1)
    return mixed @ w_o


def sq_relu_mlp(h, w1, w2):
    return jnp.square(jax.nn.relu(h @ w1)) @ w2


def setup_inputs(seed: int = 0) -> dict:
    key = jax.random.key(seed)
    ks = jax.random.split(key, 17)
    f32 = jnp.float32
    nrm = lambda k, shape, s: jax.random.normal(k, shape, f32) * s
    return {
        "x": nrm(ks[0], (BATCH, SEQ, D_MODEL), 1.0),
        "c": nrm(ks[1], (BATCH, D_MODEL), 1.0),
        "ctx": nrm(ks[2], (BATCH, CTX_LEN, D_MODEL), 1.0),
        "c_ctx": nrm(ks[3], (D_MODEL,), 1.0),
        "w_ada": nrm(ks[4], (DEPTH, D_MODEL, N_MOD * D_MODEL), D_MODEL ** -0.5),
        "b_ada": nrm(ks[5], (DEPTH, N_MOD * D_MODEL), 0.02),
        "g_norm1": 1.0 + nrm(ks[6], (DEPTH, D_MODEL), 0.05),
        "w_in": nrm(ks[7], (DEPTH, D_MODEL, IN_COLS), D_MODEL ** -0.5),
        "rpb": nrm(ks[8], (DEPTH, NA_HEADS, 2 * WIN_R - 1, 2 * WIN_C - 1), 0.1),
        "conv_w": nrm(ks[9], (DEPTH, CONV_K, CONV_WIDTH), CONV_K ** -0.5),
        "g_na_out": 1.0 + nrm(ks[10], (DEPTH, NA_WIDTH), 0.05),
        "g_conv_out": 1.0 + nrm(ks[11], (DEPTH, CONV_WIDTH), 0.05),
        "w_out": nrm(ks[12], (DEPTH, MIX_WIDTH, D_MODEL), MIX_WIDTH ** -0.5),
        "g_norm2": 1.0 + nrm(ks[13], (DEPTH, D_MODEL), 0.05),
        "w_mlp1": nrm(ks[14], (DEPTH, D_MODEL, D_FF), D_MODEL ** -0.5),
        "w_mlp2": nrm(ks[15], (DEPTH, D_FF, D_MODEL), D_FF ** -0.5),
        "g_final": 1.0 + nrm(ks[16], (D_MODEL,), 0.05),
    }


def reference(x, c, ctx, c_ctx, w_ada, b_ada, g_norm1, w_in, rpb, conv_w, g_na_out, g_conv_out,
              w_out, g_norm2, w_mlp1, w_mlp2, g_final):
    s_lat = jax.nn.silu(c)
    s_ctx = jax.nn.silu(c_ctx)
    for i in range(DEPTH):
        last = i == DEPTH - 1
        m_lat = (s_lat @ w_ada[i] + b_ada[i])[:, None, :]
        sh1, sc1, gt1, sh2, sc2, gt2 = jnp.split(m_lat, N_MOD, axis=-1)
        m_ctx = s_ctx @ w_ada[i] + b_ada[i]
        csh1, csc1, cgt1, csh2, csc2, cgt2 = jnp.split(m_ctx, N_MOD, axis=-1)

        h_lat = modulate(rms_norm(x, g_norm1[i]), sh1, sc1)
        h_ctx = modulate(rms_norm(ctx, g_norm1[i]), csh1, csc1)
        q, k, v, bg, cg, u = jnp.split(h_lat @ w_in[i], IN_SPLITS, axis=-1)
        qc, kc, vc, bgc, cgc, uc = jnp.split(h_ctx @ w_in[i], IN_SPLITS, axis=-1)
        k_ctx_h, v_ctx_h = to_heads(kc), to_heads(vc)

        o_na = from_heads(neighbourhood_attention(to_heads(q), to_heads(k), to_heads(v),
                                                  k_ctx_h, v_ctx_h, rpb[i]))
        o_conv = conv_mixer(bg, cg, u, conv_w[i])
        x_new = x + gt1 * merge_and_project(o_na, o_conv, g_na_out[i], g_conv_out[i], w_out[i])

        if not last:
            oc_na = from_heads(context_attention(to_heads(qc), k_ctx_h, v_ctx_h))
            oc_conv = conv_mixer(bgc, cgc, uc, conv_w[i])
            ctx = ctx + cgt1 * merge_and_project(oc_na, oc_conv, g_na_out[i], g_conv_out[i], w_out[i])
            hc2 = modulate(rms_norm(ctx, g_norm2[i]), csh2, csc2)
            ctx = ctx + cgt2 * sq_relu_mlp(hc2, w_mlp1[i], w_mlp2[i])

        h2 = modulate(rms_norm(x_new, g_norm2[i]), sh2, sc2)
        x = x_new + gt2 * sq_relu_mlp(h2, w_mlp1[i], w_mlp2[i])
    return rms_norm(x, g_final)
```

```cpp
#include <hip/hip_runtime.h>
#include <cstdio>
#include <cstdint>
namespace pg8 {
#define PG8_LAS __attribute__((address_space(3)))
typedef unsigned short bf16_t;
typedef short bf16x8 __attribute__((ext_vector_type(8)));
typedef float f32x4 __attribute__((ext_vector_type(4)));
typedef unsigned u32x4 __attribute__((ext_vector_type(4)));
constexpr int BM = 256, BK = 64, HALF = 128, HTB = HALF * BK * 2  , STAGE_BYTES = 8 * HTB, NXCD = 8, WGM = 8;

__host__ __device__ __forceinline__ int lds_byte(int r, int c) { const int st = (r >> 4) * 2 + (c >> 5), rr = r & 15, cc = c & 31, ob = rr * 64 + cc * 2; return st * 1024 + (ob ^ (((ob >> 9) & 1) << 5)); }
__host__ __device__ __forceinline__ void stage_rc(int b, int& R, int& C) { const int st = b / 1024, sb = b % 1024, swz = sb ^ (((sb >> 9) & 1) << 5); R = (st >> 1) * 16 + swz / 64; C = (st & 1) * 32 + (swz % 64) / 2; }
__host__ __device__ __forceinline__ int perm32(int rho) { const int n = rho >> 4, i = rho & 15; return 8 * (i >> 2) + 4 * n + (i & 3); }

struct Unit { int pm, pn; };
struct Gemm { const bf16_t* A; const bf16_t* Bt; int M, N, K; };

struct StaticOrder {
    int nM, nN, nwg, G, c;
    __host__ __device__ void init(int M, int N, int G_, int c_) { nM = M / BM; nN = N / BM; nwg = nM * nN; G = G_; c = c_; }
    __host__ __device__ bool next(int i, Unit& u) const {
        const long L = (long)i * G + c; if (L >= nwg) return false;
        int wgid = (int)L; { const int q = nwg / NXCD, r = nwg % NXCD, xcd = wgid % NXCD, off = wgid / NXCD; wgid = (xcd < r ? xcd * (q + 1) : r * (q + 1) + (xcd - r) * q) + off; }
        const int nig = WGM * nN, gid = wgid / nig, fm = gid * WGM, gsz = (nM - fm) < WGM ? (nM - fm) : WGM;
        u.pm = fm + ((wgid % nig) % gsz); u.pn = (wgid % nig) / gsz; return true;
    }
    __device__ __forceinline__ void a_ready(const Unit&) const {}
    __device__ __forceinline__ void done(const Unit&) const {}
};


__device__ __forceinline__ unsigned cvt_pk_bf16(float lo, float hi) { unsigned r; asm volatile("v_cvt_pk_bf16_f32 %0, %1, %2" : "=v"(r) : "v"(lo), "v"(hi)); return r; }

template <int ACT  > struct EpiBf16 {
    static constexpr bool PERM = true, AFTER_DRAIN = false;
    bf16_t* O; int ldc;
    __device__ __forceinline__ void operator()(const f32x4 (&acc)[2][2][4][2], const Unit& u, int wr, int wc, int fr, int fq) const {
        const int row0 = u.pm * BM + wr * 64 + fr; const int col0 = u.pn * BM + wc * 32 + 8 * fq;
#pragma unroll
        for (int ai = 0; ai < 2; ++ai)
#pragma unroll
            for (int m = 0; m < 4; ++m) { bf16_t* rowp = O + (size_t)(row0 + ai * HALF + m * 16) * ldc + col0;
#pragma unroll
                for (int bj = 0; bj < 2; ++bj) { f32x4 v0 = acc[ai][bj][m][0], v1 = acc[ai][bj][m][1];
                    if (ACT == 2) {
#pragma unroll
                        for (int e = 0; e < 4; ++e) { const float a = fmaxf(v0[e], 0.f), b = fmaxf(v1[e], 0.f); v0[e] = a * a; v1[e] = b * b; } }
                    u32x4 w; w.x = cvt_pk_bf16(v0[0], v0[1]); w.y = cvt_pk_bf16(v0[2], v0[3]); w.z = cvt_pk_bf16(v1[0], v1[1]); w.w = cvt_pk_bf16(v1[2], v1[3]);
                    *(u32x4*)(rowp + bj * HALF) = w; } }
    }
};

struct EpiGateRes {
    static constexpr bool PERM = false, AFTER_DRAIN = false;
    const float* base_lat; const float* base_ctx; float* out; const float* gate; int ldc; int gstride;
    __device__ __forceinline__ void operator()(const f32x4 (&acc)[2][2][4][2], const Unit& u, int wr, int wc, int fr, int fq) const {
        const int col0 = u.pn * BM + wc * 32 + 4 * fq;
        const bool lat = u.pm < 128;
        const float* gb = gate + (size_t)(lat ? (u.pm >> 5) : 4) * gstride + col0;
        const size_t roff = (size_t)(wr * 64 + fr) * ldc + col0;
        const float* bp = (lat ? base_lat + (size_t)u.pm * BM * ldc : base_ctx + (size_t)(u.pm - 128) * BM * ldc) + roff;
        float* op = out + (size_t)u.pm * BM * ldc + roff;
        f32x4 gv[2][2];
#pragma unroll
        for (int bj = 0; bj < 2; ++bj)
#pragma unroll
            for (int n = 0; n < 2; ++n) gv[bj][n] = *(const f32x4*)(gb + bj * HALF + n * 16);
#pragma unroll
        for (int ai = 0; ai < 2; ++ai)
#pragma unroll
            for (int m = 0; m < 4; ++m) { const size_t off = (size_t)(ai * HALF + m * 16) * ldc;
                f32x4 bs[2][2];
#pragma unroll
                for (int bj = 0; bj < 2; ++bj)
#pragma unroll
                    for (int n = 0; n < 2; ++n) bs[bj][n] = *(const f32x4*)(bp + off + bj * HALF + n * 16);
#pragma unroll
                for (int bj = 0; bj < 2; ++bj)
#pragma unroll
                    for (int n = 0; n < 2; ++n) *(f32x4*)(op + off + bj * HALF + n * 16) = bs[bj][n] + gv[bj][n] * acc[ai][bj][m][n];
                asm volatile("" ::: "memory"); }
    }
};

template <class Epi, class Sched, bool ALIGN_EPI = false, bool SP2 = false>
__device__ __forceinline__ void gemm_phase(PG8_LAS unsigned char* lds, const Gemm g, const Sched& S, const Epi& E, const int tid_in) {
    const int tid = tid_in, wid = __builtin_amdgcn_readfirstlane(tid >> 6), lane = tid & 63, wr = wid >> 2, wc = wid & 3, fr = lane & 15, fq = lane >> 4;
    const int K = g.K, nt = K / BK;
    unsigned voffA[2], voffB[2];
#pragma unroll
    for (int i = 0; i < 2; ++i) { int R, C; stage_rc(tid * 16 + i * 8192, R, C); const int Rb = Epi::PERM ? ((R & ~31) + perm32(R & 31)) : R;
        voffA[i] = (unsigned)(R * K + C) * 2u; voffB[i] = (unsigned)(Rb * K + C) * 2u; }
    const size_t kstep = (size_t)(BK * 2);
    const size_t hstep = (size_t)HALF * K * 2;
    const size_t tstep = 2 * hstep;
    const unsigned ldsw = (unsigned)wid * 1024u;
    const int aoff = lds_byte(wr * 64 + fr, fq * 8), boff = lds_byte(wc * 32 + fr, fq * 8);
#define PG8_SA(b, h) (((b) * 2 + (h)) * HTB)
#define PG8_SB(b, h) ((4 + (b) * 2 + (h)) * HTB)
#define PG8_STAGE(bufoff, gbase, voff) do { _Pragma("unroll") for (int _i = 0; _i < 2; ++_i) \
        __builtin_amdgcn_global_load_lds((const unsigned*)((const char*)(gbase) + (voff)[_i]), (PG8_LAS unsigned*)(lds + (bufoff) + ldsw + _i * 8192), 16, 0, 0); } while (0)
#define PG8_LDA(dst, b, h) do { _Pragma("unroll") for (int m = 0; m < 4; ++m) _Pragma("unroll") for (int k = 0; k < 2; ++k) dst[m][k] = *(const PG8_LAS bf16x8*)(lds + PG8_SA(b, h) + aoff + m * 2048 + k * 1024); } while (0)
#define PG8_LDB(dst, b, h) do { _Pragma("unroll") for (int n = 0; n < 2; ++n) _Pragma("unroll") for (int k = 0; k < 2; ++k) dst[n][k] = *(const PG8_LAS bf16x8*)(lds + PG8_SB(b, h) + boff + n * 2048 + k * 1024); } while (0)
#define PG8_MMA(ai, bj, At, Bt) do { __builtin_amdgcn_s_setprio(1); _Pragma("unroll") for (int m = 0; m < 4; ++m) _Pragma("unroll") for (int n = 0; n < 2; ++n) _Pragma("unroll") for (int k = 0; k < 2; ++k) \
        acc[ai][bj][m][n] = __builtin_amdgcn_mfma_f32_16x16x32_bf16(Bt[n][k], At[m][k], acc[ai][bj][m][n], 0, 0, 0); __builtin_amdgcn_s_setprio(0); } while (0)
#define PG8_WAIT_V(n) asm volatile("s_waitcnt vmcnt(" #n ")" ::: "memory")
#define PG8_WAIT_L(n) asm volatile("s_waitcnt lgkmcnt(" #n ")" ::: "memory")
#define PG8_BAR __builtin_amdgcn_s_barrier()
#define PG8_SCHED __builtin_amdgcn_sched_barrier(0)
    Unit cur, nxt; int ui = 0;
    if (!S.next(0, cur)) return;
    f32x4 acc[2][2][4][2];
#pragma unroll
    for (int a = 0; a < 2; ++a)
#pragma unroll
        for (int b = 0; b < 2; ++b)
#pragma unroll
            for (int m = 0; m < 4; ++m)
#pragma unroll
                for (int n = 0; n < 2; ++n) acc[a][b][m][n] = (f32x4){0.f, 0.f, 0.f, 0.f};
    bf16x8 At[4][2], B0[2][2], B1[2][2];
    const char* cA = (const char*)g.A + (size_t)cur.pm * tstep; const char* cB = (const char*)g.Bt + (size_t)cur.pn * tstep;
    S.a_ready(cur);
    if constexpr (SP2) {
        PG8_STAGE(PG8_SB(0, 0), cB, voffB); PG8_STAGE(PG8_SB(0, 1), cB + hstep, voffB); PG8_STAGE(PG8_SA(0, 0), cA, voffA); PG8_STAGE(PG8_SA(0, 1), cA + hstep, voffA);
        if (wr == 1) PG8_BAR;
        PG8_WAIT_V(2); PG8_BAR;
        PG8_STAGE(PG8_SB(1, 0), cB + kstep, voffB); PG8_STAGE(PG8_SA(1, 0), cA + kstep, voffA); PG8_STAGE(PG8_SB(1, 1), cB + hstep + kstep, voffB);
        PG8_WAIT_V(6); PG8_BAR;
    } else {
        PG8_STAGE(PG8_SB(0, 0), cB, voffB); PG8_STAGE(PG8_SA(0, 0), cA, voffA); PG8_STAGE(PG8_SB(0, 1), cB + hstep, voffB); PG8_STAGE(PG8_SA(0, 1), cA + hstep, voffA);
        if (wr == 1) PG8_BAR;
        PG8_WAIT_V(4); PG8_BAR;
        PG8_STAGE(PG8_SB(1, 0), cB + kstep, voffB); PG8_STAGE(PG8_SA(1, 0), cA + kstep, voffA); PG8_STAGE(PG8_SB(1, 1), cB + hstep + kstep, voffB);
        PG8_WAIT_V(6); PG8_BAR;
    }
    for (;;) {
        const bool has_next = S.next(ui + 1, nxt);
        const char* nA = has_next ? (const char*)g.A + (size_t)nxt.pm * tstep : cA; const char* nB = has_next ? (const char*)g.Bt + (size_t)nxt.pn * tstep : cB;
        for (int t = 0; t < nt; t += 2) {
            const bool last = (t == nt - 2);
            const char* a1 = cA + (size_t)(t + 1) * kstep;
            const char* a2 = last ? nA : cA + (size_t)(t + 2) * kstep; const char* b2 = last ? nB : cB + (size_t)(t + 2) * kstep;
            const char* a3 = a2 + kstep; const char* b3 = b2 + kstep;
            if (last && has_next) S.a_ready(nxt);
            if constexpr (SP2) {
            PG8_LDB(B0, 0, 0); PG8_LDB(B1, 0, 1); PG8_SCHED; PG8_LDA(At, 0, 0); PG8_STAGE(PG8_SA(1, 1), a1 + hstep, voffA);
            PG8_WAIT_V(8); PG8_WAIT_L(0); PG8_BAR; PG8_MMA(0, 0, At, B0); PG8_MMA(0, 1, At, B1); PG8_BAR; PG8_SCHED;
            PG8_LDA(At, 0, 1); PG8_STAGE(PG8_SB(0, 0), b2, voffB); PG8_STAGE(PG8_SB(0, 1), b2 + hstep, voffB); PG8_STAGE(PG8_SA(0, 0), a2, voffA);
            PG8_WAIT_V(8); PG8_WAIT_L(0); PG8_BAR; PG8_MMA(1, 0, At, B0); PG8_MMA(1, 1, At, B1); PG8_BAR; PG8_SCHED;
            PG8_LDB(B0, 1, 0); PG8_LDB(B1, 1, 1); PG8_SCHED; PG8_LDA(At, 1, 0); PG8_STAGE(PG8_SA(0, 1), a2 + hstep, voffA);
            PG8_WAIT_V(8); PG8_WAIT_L(0); PG8_BAR; PG8_MMA(0, 0, At, B0); PG8_MMA(0, 1, At, B1); PG8_BAR; PG8_SCHED;
            PG8_LDA(At, 1, 1); PG8_STAGE(PG8_SB(1, 0), b3, voffB); PG8_STAGE(PG8_SB(1, 1), b3 + hstep, voffB); PG8_STAGE(PG8_SA(1, 0), a3, voffA);
            PG8_WAIT_V(8); PG8_WAIT_L(0); PG8_BAR; PG8_MMA(1, 0, At, B0); PG8_MMA(1, 1, At, B1); PG8_BAR; PG8_SCHED;
            } else {
            PG8_LDB(B0, 0, 0); PG8_SCHED; PG8_LDA(At, 0, 0); PG8_STAGE(PG8_SA(1, 1), a1 + hstep, voffA);
            PG8_WAIT_L(8); PG8_BAR; PG8_WAIT_L(0); PG8_MMA(0, 0, At, B0); PG8_BAR; PG8_SCHED;
            PG8_LDB(B1, 0, 1); PG8_STAGE(PG8_SB(0, 0), b2, voffB);
            PG8_BAR; PG8_WAIT_L(0); PG8_MMA(0, 1, At, B1); PG8_BAR;
            PG8_LDA(At, 0, 1); PG8_STAGE(PG8_SA(0, 0), a2, voffA);
            PG8_BAR; PG8_WAIT_L(0); PG8_MMA(1, 0, At, B0); PG8_BAR; PG8_SCHED;
            PG8_STAGE(PG8_SB(0, 1), b2 + hstep, voffB);
            PG8_WAIT_V(6); PG8_BAR; PG8_MMA(1, 1, At, B1); PG8_BAR;
            PG8_LDB(B0, 1, 0); PG8_SCHED; PG8_LDA(At, 1, 0); PG8_STAGE(PG8_SA(0, 1), a2 + hstep, voffA);
            PG8_WAIT_L(8); PG8_BAR; PG8_WAIT_L(0); PG8_MMA(0, 0, At, B0); PG8_BAR; PG8_SCHED;
            PG8_LDB(B1, 1, 1); PG8_STAGE(PG8_SB(1, 0), b3, voffB);
            PG8_BAR; PG8_WAIT_L(0); PG8_MMA(0, 1, At, B1); PG8_BAR;
            PG8_LDA(At, 1, 1); PG8_STAGE(PG8_SA(1, 0), a3, voffA);
            PG8_BAR; PG8_WAIT_L(0); PG8_MMA(1, 0, At, B0); PG8_BAR; PG8_SCHED;
            PG8_STAGE(PG8_SB(1, 1), b3 + hstep, voffB);
            PG8_WAIT_V(6); PG8_BAR; PG8_MMA(1, 1, At, B1); PG8_BAR;
            }
        }
        if constexpr (ALIGN_EPI) { if (wr == 0) PG8_BAR; }
        if constexpr (!Epi::AFTER_DRAIN) { E(acc, cur, wr, wc, fr, fq); S.done(cur); }
        if (!has_next) break;
#pragma unroll
        for (int a = 0; a < 2; ++a)
#pragma unroll
            for (int b = 0; b < 2; ++b)
#pragma unroll
                for (int m = 0; m < 4; ++m)
#pragma unroll
                    for (int n = 0; n < 2; ++n) acc[a][b][m][n] = (f32x4){0.f, 0.f, 0.f, 0.f};
        cur = nxt; cA = nA; cB = nB; ++ui;
        if constexpr (ALIGN_EPI) { if (wr == 1) PG8_BAR; }
    }
    PG8_WAIT_V(0);
    if constexpr (!ALIGN_EPI) { if (wr == 0) PG8_BAR; }
    PG8_BAR;
    if constexpr (Epi::AFTER_DRAIN) { E.fused(acc, cur, wr, wc, fr, fq, lds, wid, lane); S.done(cur); }
#undef PG8_SA
#undef PG8_SB
#undef PG8_STAGE
#undef PG8_LDA
#undef PG8_LDB
#undef PG8_MMA
#undef PG8_WAIT_V
#undef PG8_WAIT_L
#undef PG8_BAR
#undef PG8_SCHED
}
}

constexpr int NWAVES = 8;
#ifndef MK_PER_PHASE
#define MK_PER_PHASE 0
#endif

constexpr int DM = 2048, NB = 4, SEQ = 8192, DEPTH = 4, CTXL = 256, GRID_W = 64, GRID_R = SEQ / GRID_W;
constexpr int NAW = 1024, NH = 8, HD = 128, CVW = 1024, INC = 6144, DFF = 8192, NMOD = 6, MODW = NMOD * DM;
constexpr int WIN_R = 8, WIN_C = 16, RPB_R = 2 * WIN_R - 1, RPB_C = 2 * WIN_C - 1, RPB_HS = RPB_R * RPB_C;
constexpr int MLAT = NB * SEQ, MCTX = NB * CTXL, MT = MLAT + MCTX;
constexpr float EPS = 1e-6f;
constexpr int COL_Q = 0, COL_K = NAW, COL_V = 2 * NAW, COL_BG = 3 * NAW, COL_CG = 3 * NAW + CVW, COL_U = 3 * NAW + 2 * CVW;
constexpr int N_PHASES = 2 + 7 * DEPTH;

constexpr size_t MiB = 1u << 20;
constexpr size_t WS_CTL = 0, CTL_ZERO_BYTES = 1 * MiB;
constexpr size_t WS_MOD = 1 * MiB;
constexpr size_t WS_VEC = 2 * MiB;
constexpr size_t WS_WIN = 3 * MiB, WS_WOUT = 99 * MiB, WS_W1 = 131 * MiB, WS_W2 = 259 * MiB;
constexpr size_t WS_X = 387 * MiB;
constexpr size_t WS_XN = 651 * MiB;
constexpr size_t WS_P = 783 * MiB;
constexpr size_t WS_MIX = 1179 * MiB;
constexpr size_t WS_H = 783 * MiB;
constexpr size_t WS_END = 1311 * MiB;
constexpr int VEC_G1 = 0, VEC_G2 = DM, VEC_RPB = 2 * DM, VEC_CW = VEC_RPB + 3728, VEC_GNA = VEC_CW + 3 * CVW, VEC_GCV = VEC_GNA + NAW, VEC_L = VEC_GCV + CVW, VEC_GF = DEPTH * VEC_L;
static_assert(NH * RPB_HS <= 3728 && (size_t)(VEC_GF + DM) * 4 <= MiB && VEC_CW % 4 == 0 && VEC_L % 4 == 0, "VEC map");
static_assert((size_t)DEPTH * 5 * MODW * 4 <= MiB && WS_WIN + (size_t)DEPTH * INC * DM * 2 <= WS_WOUT && WS_WOUT + (size_t)DEPTH * DM * DM * 2 <= WS_W1 && WS_W1 + (size_t)DEPTH * DFF * DM * 2 <= WS_W2 &&
              WS_W2 + (size_t)DEPTH * DFF * DM * 2 <= WS_X && WS_X + (size_t)MT * DM * 4 <= WS_XN && WS_XN + (size_t)MT * DM * 2 <= WS_P && WS_P + (size_t)MT * INC * 2 <= WS_MIX &&
              WS_MIX + (size_t)MT * DM * 2 <= WS_END && WS_H + (size_t)MT * DFF * 2 <= WS_END, "d_ws map");
constexpr int CW_BAR = 4096;

constexpr int RING_OFF = 0, RING_BYTES = 131072;
constexpr int LDSCTL_OFF = RING_BYTES, MISC_OFF = LDSCTL_OFF + 320;
constexpr int LDS_BYTES = 147456;
static_assert(MISC_OFF + 128 <= LDS_BYTES, "LDS map");

#define GAS __attribute__((address_space(1)))
#define LAS __attribute__((address_space(3)))
typedef unsigned short bf16;
typedef unsigned v4u __attribute__((ext_vector_type(4)));
typedef float f32x4 __attribute__((ext_vector_type(4)));
typedef short bf16x8 __attribute__((ext_vector_type(8)));
typedef GAS unsigned gu32;
typedef GAS unsigned long long gu64;
#define RLX_AGENT __ATOMIC_RELAXED, __HIP_MEMORY_SCOPE_AGENT
#define LDS_WAIT() asm volatile("s_waitcnt lgkmcnt(0)" ::: "memory")
#define VM_WAIT() asm volatile("s_waitcnt vmcnt(0)" ::: "memory")
__device__ __forceinline__ unsigned long long rt() { return __builtin_amdgcn_s_memrealtime(); }
__device__ __forceinline__ unsigned f2bf(float f) { unsigned u = __builtin_bit_cast(unsigned, f); return (u + 0x7fffu + ((u >> 16) & 1u)) >> 16; }
__device__ __forceinline__ unsigned pk2(float lo, float hi) { return f2bf(lo) | (f2bf(hi) << 16); }

#define XB_TMO      128
#define XB_XCNT(j)  (256  + 64 * (j))
#define XB_XSUB(j)  (1280 + 64 * (j))
#define XB_XGEN(j)  (2304 + 64 * (j))
#define XB_TOP      3328
#define XB_TOPGEN   3392
#define XCD_BAR_WORDS 3456
#define XB_SPIN_CAP (1u << 18)

__device__ __forceinline__ unsigned xb_ld(unsigned* p)              { return __hip_atomic_load(p, __ATOMIC_RELAXED, __HIP_MEMORY_SCOPE_AGENT); }
__device__ __forceinline__ unsigned xb_add(unsigned* p, unsigned v) { return __hip_atomic_fetch_add(p, v, __ATOMIC_RELAXED, __HIP_MEMORY_SCOPE_AGENT); }
__device__ __forceinline__ unsigned xb_xcc_id() { return (unsigned)__builtin_amdgcn_s_getreg((3 << 11) | 20) & 0xFu; }
#define XB_SPIN(cond, bar) do { unsigned _sp = 0; while (cond) { __builtin_amdgcn_s_sleep(1); \
    if ((++_sp & 255u) == 0u) { if (xb_ld(&(bar)[XB_TMO])) break; if (_sp > XB_SPIN_CAP) { atomicAdd(&(bar)[XB_TMO], 1u); break; } } } } while (0)

struct XcdBarrier {
    unsigned* bar; unsigned x;
    volatile LAS unsigned* st;
};

__device__ __forceinline__ XcdBarrier xcd_barrier_post(unsigned* bar, volatile LAS unsigned* st) {
    XcdBarrier b; b.bar = bar; b.x = xb_xcc_id(); b.st = st;
    if (threadIdx.x == 0) (void)xb_add(&bar[XB_XCNT(b.x)], 1u);
    return b;
}
__device__ __forceinline__ void xcd_barrier_complete(unsigned* bar, unsigned x, unsigned& nloc, unsigned& nx) {
    const unsigned G = gridDim.x * gridDim.y * gridDim.z;
    unsigned sum, cnt, mine, sp = 0u;
    for (;;) {
        sum = 0u; cnt = 0u; mine = 0u;
#pragma unroll
        for (unsigned j = 0; j < 16; ++j) { const unsigned c = xb_ld(&bar[XB_XCNT(j)]); sum += c; cnt += (c > 0u) ? 1u : 0u; mine = (j == x) ? c : mine; }
        if (sum == G) break;
        __builtin_amdgcn_s_sleep(1);
        if ((++sp & 255u) == 0u) { if (xb_ld(&bar[XB_TMO])) break; if (sp > XB_SPIN_CAP) { atomicAdd(&bar[XB_TMO], 1u); break; } }
    }
    nloc = mine > 0u ? mine : 1u; nx = cnt > 0u ? cnt : 1u;
}

__device__ __forceinline__ void xcd_barrier(const XcdBarrier& b) {
    asm volatile("s_waitcnt vmcnt(0)" ::: "memory");
    __syncthreads();
    if (threadIdx.x == 0) {
        unsigned* bar = b.bar;
        __builtin_amdgcn_s_waitcnt(0);
        unsigned nloc = b.st[0], nx = b.st[1];
        if (nloc == 0u) { xcd_barrier_complete(bar, b.x, nloc, nx); b.st[0] = nloc; b.st[1] = nx; }
        const unsigned old = xb_add(&bar[XB_XSUB(b.x)], 1u);
        const unsigned gen = old / nloc;
        if (old + 1u == (gen + 1u) * nloc) {
            __builtin_amdgcn_fence(__ATOMIC_RELEASE, "agent");
            asm volatile("s_waitcnt vmcnt(0)" ::: "memory");
            const unsigned og = xb_add(&bar[XB_TOP], 1u);
            const unsigned tg = og / nx;
            if (og + 1u == (tg + 1u) * nx) xb_add(&bar[XB_TOPGEN], 1u);
            else XB_SPIN(xb_ld(&bar[XB_TOPGEN]) == tg, bar);
            __builtin_amdgcn_fence(__ATOMIC_ACQUIRE, "agent");
            xb_add(&bar[XB_XGEN(b.x)], 1u);
            asm volatile("s_waitcnt vmcnt(0)" ::: "memory");
        } else {
            XB_SPIN(xb_ld(&bar[XB_XGEN(b.x)]) == gen, bar);
            __builtin_amdgcn_fence(__ATOMIC_ACQUIRE, "agent");
            asm volatile("s_waitcnt vmcnt(0)" ::: "memory");
        }
    }
    __syncthreads();
}

struct Frame {
    LAS unsigned char* lds;
    volatile LAS unsigned* MISC;
    gu32* ctl;
    int tid, lane, wave;
    int vcu, G;
};
typedef unsigned u32x2 __attribute__((ext_vector_type(2)));
typedef short v4i16_t __attribute__((ext_vector_type(4)));
typedef float f32x4v __attribute__((ext_vector_type(4)));

__device__ __forceinline__ float wave_sum(float v) {
#pragma unroll
    for (int o = 1; o < 64; o <<= 1) v += __shfl_xor(v, o);
    return v;
}
__device__ __forceinline__ float bf_lo(unsigned w) { return __uint_as_float(w << 16); }
__device__ __forceinline__ float bf_hi(unsigned w) { return __uint_as_float(w & 0xffff0000u); }

__device__ __forceinline__ void p0_transpose_item(const float* W, int K, int N, bf16* WT, LAS float* scr, int item, int lane) {
    const int nblk = N / 32, kb = item / nblk, nb = item % nblk, k0 = 64 * kb, n0 = 32 * nb;
#pragma unroll 8
    for (int i = 0; i < 32; ++i) { const int kk = 2 * i + (lane >> 5); scr[kk * 33 + (lane & 31)] = W[(size_t)(k0 + kk) * N + n0 + (lane & 31)]; }
    LDS_WAIT(); asm volatile("" ::: "memory");
    const int c = lane & 7;
#pragma unroll
    for (int j = 0; j < 4; ++j) { const int n = (lane >> 3) + 8 * j; const LAS float* s = scr + (8 * c) * 33 + n;
        v4u o; o.x = pk2(s[0 * 33], s[1 * 33]); o.y = pk2(s[2 * 33], s[3 * 33]); o.z = pk2(s[4 * 33], s[5 * 33]); o.w = pk2(s[6 * 33], s[7 * 33]);
        *(GAS v4u*)(WT + (size_t)(n0 + n) * K + k0 + 8 * c) = o; }
    LDS_WAIT(); asm volatile("" ::: "memory");
}
struct ProIn { const float *c, *c_ctx, *w_ada, *b_ada, *w_in, *w_out, *w1, *w2, *g1, *g2, *rpb, *cw, *gna, *gcv, *gf; float* mod; float* vec; bf16 *win_t, *wout_t, *w1_t, *w2_t; };
__device__ __forceinline__ void p0_prologue(Frame& F, const ProIn& I) {
    LAS float* S = (LAS float*)(F.lds + RING_OFF);
    LAS float* RED = S + 5 * DM;
    for (int i = F.tid; i < 5 * DM; i += NWAVES * 64) { const int r = i / DM, k = i % DM; const float v = r < 4 ? I.c[r * DM + k] : I.c_ctx[k]; S[i] = v / (1.0f + __expf(-v)); }
    __syncthreads();
    constexpr int NSLAB = DEPTH * (MODW / 64);
    for (int slab = blockIdx.x; slab < NSLAB; slab += F.G) {
        const int l = slab / (MODW / 64), n0 = (slab % (MODW / 64)) * 64;
        const float* wp = I.w_ada + (size_t)l * DM * MODW + (size_t)(F.wave * 256) * MODW + n0 + F.lane;
        float a0 = 0.f, a1 = 0.f, a2 = 0.f, a3 = 0.f, a4 = 0.f;
        const LAS float* s0 = S + F.wave * 256;
#pragma unroll 16
        for (int k = 0; k < 256; ++k) { const float w = wp[(size_t)k * MODW];
            a0 += s0[k] * w; a1 += s0[DM + k] * w; a2 += s0[2 * DM + k] * w; a3 += s0[3 * DM + k] * w; a4 += s0[4 * DM + k] * w; }
        LAS float* rd = RED + F.wave * 320 + F.lane;
        rd[0] = a0; rd[64] = a1; rd[128] = a2; rd[192] = a3; rd[256] = a4;
        __syncthreads();
        if (F.tid < 320) { float s = 0.f;
#pragma unroll
            for (int w = 0; w < 8; ++w) s += RED[w * 320 + F.tid];
            const int r = F.tid >> 6, n = n0 + (F.tid & 63);
            I.mod[((size_t)l * 5 + r) * MODW + n] = s + I.b_ada[(size_t)l * MODW + n]; }
        __syncthreads();
    }
    __syncthreads();
    { const int gt = blockIdx.x * (NWAVES * 64) + F.tid, NGT = F.G * NWAVES * 64;
      for (int i = gt; i < DEPTH * VEC_L + DM; i += NGT) {
          float v;
          if (i >= VEC_GF) v = I.gf[i - VEC_GF];
          else { const int l = i / VEC_L, r = i % VEC_L;
              if (r < VEC_G2) v = I.g1[l * DM + r];
              else if (r < VEC_RPB) v = I.g2[l * DM + r - VEC_G2];
              else if (r < VEC_CW) v = (r - VEC_RPB) < NH * RPB_HS ? I.rpb[l * NH * RPB_HS + r - VEC_RPB] : 0.f;
              else if (r < VEC_GNA) v = I.cw[l * 3 * CVW + r - VEC_CW];
              else if (r < VEC_GCV) v = I.gna[l * NAW + r - VEC_GNA];
              else v = I.gcv[l * CVW + r - VEC_GCV]; }
          I.vec[i] = v; } }
    LAS float* scr = (LAS float*)(F.lds + RING_OFF + F.wave * 16384);
    const int gw = F.vcu * NWAVES + F.wave, NGW = F.G * NWAVES;
    constexpr int I_IN = (DM / 64) * (INC / 32), I_OUT = (DM / 64) * (DM / 32), I_1 = (DM / 64) * (DFF / 32), I_2 = (DFF / 64) * (DM / 32);
    constexpr int I_L = I_IN + I_OUT + I_1 + I_2, NITEMS = DEPTH * I_L;
    for (int it = gw; it < NITEMS; it += NGW) {
        const int l = it / I_L; int r = it % I_L;
        if (r < I_IN) { p0_transpose_item(I.w_in + (size_t)l * DM * INC, DM, INC, I.win_t + (size_t)l * INC * DM, scr, r, F.lane); continue; } r -= I_IN;
        if (r < I_OUT) { p0_transpose_item(I.w_out + (size_t)l * DM * DM, DM, DM, I.wout_t + (size_t)l * DM * DM, scr, r, F.lane); continue; } r -= I_OUT;
        if (r < I_1) { p0_transpose_item(I.w1 + (size_t)l * DM * DFF, DM, DFF, I.w1_t + (size_t)l * DFF * DM, scr, r, F.lane); continue; } r -= I_1;
        p0_transpose_item(I.w2 + (size_t)l * DFF * DM, DFF, DM, I.w2_t + (size_t)l * DM * DFF, scr, r, F.lane);
    }
}

__device__ __forceinline__ void norm_mod_phase(Frame& F, const float* src_lat, const float* src_ctx, const float* g, const float* mod_l, int sh_off, int sc_off, bf16* XN) {
    const int gw = F.vcu * NWAVES + F.wave, NGW = F.G * NWAVES;
    for (int row = gw; row < MT; row += NGW) {
        const bool lat = row < MLAT;
        const float* xr = lat ? src_lat + (size_t)row * DM : src_ctx + (size_t)(row - MLAT) * DM;
        const float* mr = mod_l + (size_t)(lat ? (row >> 13) : 4) * MODW;
        f32x4v v[8]; float ss = 0.f;
#pragma unroll
        for (int j = 0; j < 8; ++j) { v[j] = *(const f32x4v*)(xr + 256 * j + 4 * F.lane); ss += (v[j].x * v[j].x + v[j].y * v[j].y) + (v[j].z * v[j].z + v[j].w * v[j].w); }
        const float rstd = rsqrtf(wave_sum(ss) * (1.0f / DM) + EPS);
#pragma unroll
        for (int j = 0; j < 8; ++j) { const int c = 256 * j + 4 * F.lane;
            const f32x4v gg = *(const f32x4v*)(g + c), sc = *(const f32x4v*)(mr + sc_off + c), sh = *(const f32x4v*)(mr + sh_off + c);
            const f32x4v y = (v[j] * rstd) * gg * (sc + 1.0f) + sh;
            u32x2 o; o.x = pk2(y.x, y.y); o.y = pk2(y.z, y.w);
            *(u32x2*)(XN + (size_t)row * DM + c) = o; }
    }
}
__device__ __forceinline__ void final_norm_phase(Frame& F, const float* X, const float* g, float* out) {
    const int gw = F.vcu * NWAVES + F.wave, NGW = F.G * NWAVES;
    for (int row = gw; row < MLAT; row += NGW) {
        const float* xr = X + (size_t)row * DM;
        f32x4v v[8]; float ss = 0.f;
#pragma unroll
        for (int j = 0; j < 8; ++j) { v[j] = *(const f32x4v*)(xr + 256 * j + 4 * F.lane); ss += (v[j].x * v[j].x + v[j].y * v[j].y) + (v[j].z * v[j].z + v[j].w * v[j].w); }
        const float rstd = rsqrtf(wave_sum(ss) * (1.0f / DM) + EPS);
#pragma unroll
        for (int j = 0; j < 8; ++j) { const int c = 256 * j + 4 * F.lane; const f32x4v gg = *(const f32x4v*)(g + c);
            *(f32x4v*)(out + (size_t)row * DM + c) = (v[j] * rstd) * gg; }
    }
}

namespace mix {
constexpr int KSTR = 272, VSTR = 288;
constexpr int KBUF = 64 * KSTR, VBUF = 64 * VSTR, CHB = KBUF + VBUF;
constexpr int BIAS_OFF = 2 * CHB;
constexpr int MIX_LDS = BIAS_OFF + NH * RPB_HS * 4;
static_assert(MIX_LDS <= RING_BYTES, "mixer LDS");
constexpr float LOG2E = 1.4426950408889634f;
constexpr float SC2 = 0.08838834764831845f * LOG2E;
constexpr float NEG = -1.0e30f;

struct ChunkRegs { v4u k0, k1, v0, v1; };
__device__ __forceinline__ void chunk_load(ChunkRegs& R, const bf16* P, int tid, int h, int ci, int nloc, int a_lo, int lat0, int ctx0) {
    const int krow0 = ci < nloc ? lat0 + (a_lo + ci) * GRID_W : ctx0 + (ci - nloc) * 64;
    const int key = tid >> 4, c16 = tid & 15;
    const bf16* p0 = P + (size_t)(krow0 + key) * INC + h * HD + 8 * c16;
    const bf16* p1 = p0 + (size_t)32 * INC;
    R.k0 = *(const GAS v4u*)(p0 + COL_K); R.k1 = *(const GAS v4u*)(p1 + COL_K);
    R.v0 = *(const GAS v4u*)(p0 + COL_V); R.v1 = *(const GAS v4u*)(p1 + COL_V);
}
__device__ __forceinline__ void chunk_store(const ChunkRegs& R, LAS unsigned char* buf, int tid) {
    const int key = tid >> 4, c16 = tid & 15;
    *(LAS v4u*)(buf + key * KSTR + 16 * c16) = R.k0; *(LAS v4u*)(buf + (key + 32) * KSTR + 16 * c16) = R.k1;
    *(LAS v4u*)(buf + KBUF + key * VSTR + 16 * c16) = R.v0; *(LAS v4u*)(buf + KBUF + (key + 32) * VSTR + 16 * c16) = R.v1;
}

__device__ __forceinline__ void mixer_unit(Frame& F, int u, const bf16* P, bf16* MIXO, const float* conv_w, const float* g_na, const float* g_cv) {
    LAS unsigned char* L = F.lds + RING_OFF;
    const LAS float* btab = (const LAS float*)(L + BIAS_OFF);
    const int tid = F.tid, lane = F.lane, w = F.wave, qi = lane & 15, g = lane >> 4;
    const bool lat = u < 256;
    int b, tok0, nloc, a_lo, r0, seq_lo, seq_hi;
    if (lat) { b = u >> 6; r0 = 2 * (u & 63); tok0 = b * SEQ + r0 * GRID_W; a_lo = min(max(r0 - 4, 0), GRID_R - WIN_R); const int a_hi = min(max(r0 + 1 - 4, 0), GRID_R - WIN_R) + WIN_R - 1; nloc = a_hi - a_lo + 1;
               seq_lo = b * SEQ; seq_hi = seq_lo + SEQ; }
    else { const int v = u - 256; b = v >> 1; r0 = 0; tok0 = MLAT + b * CTXL + 128 * (v & 1); a_lo = 0; nloc = 0; seq_lo = MLAT + b * CTXL; seq_hi = seq_lo + CTXL; }
    const int lat0 = b * SEQ, ctx0 = MLAT + b * CTXL;
    const int nch = nloc + 4;
    const int rw = r0 + (w >> 2), qt = w & 3;
    const int rs_w = min(max(rw - 4, 0), GRID_R - WIN_R);
    const int cq = 16 * qt + qi;
    const int cs = min(max(cq - 8, 0), GRID_W - WIN_C);
    const unsigned need_loc = qt == 0 ? 0x3u : qt == 1 ? 0x7u : qt == 2 ? 0xEu : 0xCu;
    const int qrow = tok0 + 16 * w + qi;

    ChunkRegs CR;
    chunk_load(CR, P, tid, 0, 0, nloc, a_lo, lat0, ctx0);
    chunk_store(CR, L, tid);
    __syncthreads();

    bf16x8 qf[4]; f32x4v O[8]; float m_run = NEG, l_run = 0.f, ssq = 0.f;
    int h = 0, ci = 0;
    const int total = NH * nch;
    for (int step = 0; step < total; ++step) {
        int hn = h, cn = ci + 1; if (cn == nch) { cn = 0; ++hn; }
        const bool has_next = hn < NH;
        if (has_next) chunk_load(CR, P, tid, hn, cn, nloc, a_lo, lat0, ctx0);
        if (ci == 0) {
#pragma unroll
            for (int ks = 0; ks < 4; ++ks) qf[ks] = *(const GAS bf16x8*)(P + (size_t)qrow * INC + COL_Q + h * HD + 32 * ks + 8 * g);
#pragma unroll
            for (int dt = 0; dt < 8; ++dt) O[dt] = (f32x4v){0.f, 0.f, 0.f, 0.f};
            m_run = NEG; l_run = 0.f;
        }
        const LAS unsigned char* Kb = L + (step & 1) * CHB; const LAS unsigned char* Vb = Kb + KBUF;
        const bool is_loc = ci < nloc; const int a = a_lo + ci;
        const bool active = !is_loc || (a >= rs_w && a < rs_w + WIN_R);
        if (active) {
            const unsigned need = is_loc ? need_loc : 0xFu;
            float s[4][4];
#pragma unroll
            for (int kt = 0; kt < 4; ++kt) {
                if ((need >> kt) & 1u) {
                    f32x4v acc = (f32x4v){0.f, 0.f, 0.f, 0.f};
#pragma unroll
                    for (int ks = 0; ks < 4; ++ks) { const bf16x8 kf = *(const LAS bf16x8*)(Kb + (16 * kt + qi) * KSTR + 64 * ks + 16 * g);
                        acc = __builtin_amdgcn_mfma_f32_16x16x32_bf16(kf, qf[ks], acc, 0, 0, 0); }
                    if (is_loc) {
                        const LAS float* bt = btab + h * RPB_HS + (a - rw + WIN_R - 1) * RPB_C;
#pragma unroll
                        for (int e = 0; e < 4; ++e) { const int kc = 16 * kt + 4 * g + e; const int dcol = kc - cq + (WIN_C - 1);
                            const bool valid = (kc >= cs) && (kc < cs + WIN_C);
                            const float bv = bt[min(max(dcol, 0), RPB_C - 1)];
                            s[kt][e] = valid ? acc[e] * SC2 + bv : NEG; }
                    } else {
#pragma unroll
                        for (int e = 0; e < 4; ++e) s[kt][e] = acc[e] * SC2;
                    }
                } else {
#pragma unroll
                    for (int e = 0; e < 4; ++e) s[kt][e] = NEG;
                }
            }
            float mx = NEG;
#pragma unroll
            for (int kt = 0; kt < 4; ++kt)
#pragma unroll
                for (int e = 0; e < 4; ++e) mx = fmaxf(mx, s[kt][e]);
            mx = fmaxf(mx, __shfl_xor(mx, 16)); mx = fmaxf(mx, __shfl_xor(mx, 32));
            const float m_new = fmaxf(m_run, mx);
            const float alpha = __builtin_amdgcn_exp2f(m_run - m_new);
            m_run = m_new;
            float psum = 0.f; unsigned pk[4][2];
#pragma unroll
            for (int kt = 0; kt < 4; ++kt) { float p[4];
#pragma unroll
                for (int e = 0; e < 4; ++e) { p[e] = __builtin_amdgcn_exp2f(s[kt][e] - m_new); psum += p[e]; }
                pk[kt][0] = pk2(p[0], p[1]); pk[kt][1] = pk2(p[2], p[3]); }
            l_run = l_run * alpha + psum;
#pragma unroll
            for (int dt = 0; dt < 8; ++dt) O[dt] = O[dt] * alpha;
#pragma unroll
            for (int pp = 0; pp < 2; ++pp) {
                if ((need >> (2 * pp)) & 3u) {
                    const v4u pw = (v4u){pk[2 * pp][0], pk[2 * pp][1], pk[2 * pp + 1][0], pk[2 * pp + 1][1]};
                    const bf16x8 pf = __builtin_bit_cast(bf16x8, pw);
                    const LAS unsigned char* vrow = Vb + (32 * pp + 4 * g + (qi >> 2)) * VSTR + 8 * (qi & 3);
#pragma unroll
                    for (int dt = 0; dt < 8; ++dt) {
                        const v4i16_t lo = __builtin_amdgcn_ds_read_tr16_b64_v4i16((LAS v4i16_t*)(vrow + 32 * dt));
                        const v4i16_t hi = __builtin_amdgcn_ds_read_tr16_b64_v4i16((LAS v4i16_t*)(vrow + 16 * VSTR + 32 * dt));
                        const bf16x8 vf = (bf16x8){lo[0], lo[1], lo[2], lo[3], hi[0], hi[1], hi[2], hi[3]};
                        O[dt] = __builtin_amdgcn_mfma_f32_16x16x32_bf16(vf, pf, O[dt], 0, 0, 0);
                    }
                }
            }
        }
        if (ci == nch - 1) {
            float lt = l_run; lt += __shfl_xor(lt, 16); lt += __shfl_xor(lt, 32);
            const float inv = 1.0f / lt;
            bf16* op = MIXO + (size_t)qrow * DM + h * HD + 4 * g;
#pragma unroll
            for (int dt = 0; dt < 8; ++dt) { const f32x4v o = O[dt] * inv; ssq += (o.x * o.x + o.y * o.y) + (o.z * o.z + o.w * o.w);
                u32x2 ov; ov.x = pk2(o.x, o.y); ov.y = pk2(o.z, o.w); *(GAS u32x2*)(op + 16 * dt) = ov; }
        }
        if (has_next) chunk_store(CR, L + ((step + 1) & 1) * CHB, tid);
        __syncthreads();
        h = hn; ci = cn;
    }
    ssq += __shfl_xor(ssq, 16); ssq += __shfl_xor(ssq, 32);
    const float rstd = rsqrtf(ssq * (1.0f / NAW) + EPS);
    VM_WAIT(); __builtin_amdgcn_fence(__ATOMIC_ACQUIRE, "agent"); VM_WAIT();
    {
        bf16* op = MIXO + (size_t)qrow * DM + 4 * g;
#pragma unroll 4
        for (int i = 0; i < 64; ++i) {
            const u32x2 iv = *(const GAS u32x2*)(op + 16 * i); const f32x4v gg = *(const f32x4v*)(g_na + 16 * i + 4 * g);
            u32x2 ov; ov.x = pk2(bf_lo(iv.x) * rstd * gg.x, bf_hi(iv.x) * rstd * gg.y); ov.y = pk2(bf_lo(iv.y) * rstd * gg.z, bf_hi(iv.y) * rstd * gg.w);
            *(GAS u32x2*)(op + 16 * i) = ov; }
    }
    {
        float wk[3][2][8], gc[2][8];
#pragma unroll
        for (int j = 0; j < 2; ++j) { const int ch = 8 * lane + 512 * j;
#pragma unroll
            for (int k = 0; k < 3; ++k) { const f32x4v a0 = *(const f32x4v*)(conv_w + k * CVW + ch), a1 = *(const f32x4v*)(conv_w + k * CVW + ch + 4);
                wk[k][j][0] = a0.x; wk[k][j][1] = a0.y; wk[k][j][2] = a0.z; wk[k][j][3] = a0.w; wk[k][j][4] = a1.x; wk[k][j][5] = a1.y; wk[k][j][6] = a1.z; wk[k][j][7] = a1.w; }
            const f32x4v c0 = *(const f32x4v*)(g_cv + ch), c1 = *(const f32x4v*)(g_cv + ch + 4);
            gc[j][0] = c0.x; gc[j][1] = c0.y; gc[j][2] = c0.z; gc[j][3] = c0.w; gc[j][4] = c1.x; gc[j][5] = c1.y; gc[j][6] = c1.z; gc[j][7] = c1.w; }
        float cu[3][2][8];
        const int t0 = tok0 + 16 * w;
#define MIX_LOAD_CU(dst, row) do { const bool ok_ = (row) >= seq_lo && (row) < seq_hi; _Pragma("unroll") for (int j = 0; j < 2; ++j) { \
            v4u a_ = (v4u){0u, 0u, 0u, 0u}, b_ = (v4u){0u, 0u, 0u, 0u}; \
            if (ok_) { a_ = *(const GAS v4u*)(P + (size_t)(row) * INC + COL_CG + 8 * lane + 512 * j); b_ = *(const GAS v4u*)(P + (size_t)(row) * INC + COL_U + 8 * lane + 512 * j); } \
            dst[j][0] = bf_lo(a_.x) * bf_lo(b_.x); dst[j][1] = bf_hi(a_.x) * bf_hi(b_.x); dst[j][2] = bf_lo(a_.y) * bf_lo(b_.y); dst[j][3] = bf_hi(a_.y) * bf_hi(b_.y); \
            dst[j][4] = bf_lo(a_.z) * bf_lo(b_.z); dst[j][5] = bf_hi(a_.z) * bf_hi(b_.z); dst[j][6] = bf_lo(a_.w) * bf_lo(b_.w); dst[j][7] = bf_hi(a_.w) * bf_hi(b_.w); } } while (0)
        MIX_LOAD_CU(cu[0], t0 - 1); MIX_LOAD_CU(cu[1], t0);
        for (int t = 0; t < 16; ++t) {
            const int row = t0 + t;
            MIX_LOAD_CU(cu[2], row + 1);
            float o[2][8]; float ss = 0.f;
#pragma unroll
            for (int j = 0; j < 2; ++j) { const v4u bgv = *(const GAS v4u*)(P + (size_t)row * INC + COL_BG + 8 * lane + 512 * j);
                const float bgf[8] = {bf_lo(bgv.x), bf_hi(bgv.x), bf_lo(bgv.y), bf_hi(bgv.y), bf_lo(bgv.z), bf_hi(bgv.z), bf_lo(bgv.w), bf_hi(bgv.w)};
#pragma unroll
                for (int e = 0; e < 8; ++e) { const float cvv = wk[0][j][e] * cu[0][j][e] + wk[1][j][e] * cu[1][j][e] + wk[2][j][e] * cu[2][j][e]; o[j][e] = bgf[e] * cvv; ss += o[j][e] * o[j][e]; } }
            const float rs = rsqrtf(wave_sum(ss) * (1.0f / CVW) + EPS);
#pragma unroll
            for (int j = 0; j < 2; ++j) { v4u ov;
                ov.x = pk2(o[j][0] * rs * gc[j][0], o[j][1] * rs * gc[j][1]); ov.y = pk2(o[j][2] * rs * gc[j][2], o[j][3] * rs * gc[j][3]);
                ov.z = pk2(o[j][4] * rs * gc[j][4], o[j][5] * rs * gc[j][5]); ov.w = pk2(o[j][6] * rs * gc[j][6], o[j][7] * rs * gc[j][7]);
                *(GAS v4u*)(MIXO + (size_t)row * DM + NAW + 8 * lane + 512 * j) = ov; }
#pragma unroll
            for (int j = 0; j < 2; ++j)
#pragma unroll
                for (int e = 0; e < 8; ++e) { cu[0][j][e] = cu[1][j][e]; cu[1][j][e] = cu[2][j][e]; }
        }
#undef MIX_LOAD_CU
    }
}
__device__ __forceinline__ void mixer_phase(Frame& F, const bf16* P, bf16* MIXO, const float* rpb_l, const float* conv_w, const float* g_na, const float* g_cv, int n_units) {
    LAS float* btab = (LAS float*)(F.lds + RING_OFF + BIAS_OFF);
    for (int i = F.tid; i < NH * RPB_HS; i += NWAVES * 64) btab[i] = rpb_l[i] * LOG2E;
    __syncthreads();
    for (int u = F.vcu; u < n_units; u += F.G) mixer_unit(F, u, P, MIXO, conv_w, g_na, g_cv);
    __syncthreads();
}
}

struct Args { const float* in[17]; float* out; unsigned char* ws; int ph_lo, ph_hi; };
__global__ void __launch_bounds__(NWAVES * 64, 2) skel_fwd(Args args) {
    extern __shared__ __attribute__((aligned(16))) unsigned char lds[];
    Frame F;
    F.lds = (LAS unsigned char*)lds;
    F.MISC = (volatile LAS unsigned*)(F.lds + MISC_OFF);
    F.tid = threadIdx.x; F.lane = F.tid & 63; F.wave = __builtin_amdgcn_readfirstlane(F.tid >> 6);
    F.G = gridDim.x; { const int bx = blockIdx.x; F.vcu = (F.G % 8 == 0) ? (bx % 8) * (F.G / 8) + bx / 8 : bx; }
    unsigned char* ws = args.ws;
    F.ctl = (gu32*)(ws + WS_CTL);
    const float *in_x = args.in[0], *in_ctx = args.in[2];
#define MOD ((float*)(ws + WS_MOD))
#define VEC ((const float*)(ws + WS_VEC))
#define WIN_T ((bf16*)(ws + WS_WIN))
#define WOUT_T ((bf16*)(ws + WS_WOUT))
#define W1_T ((bf16*)(ws + WS_W1))
#define W2_T ((bf16*)(ws + WS_W2))
#define X ((float*)(ws + WS_X))
#define XN ((bf16*)(ws + WS_XN))
#define PB ((bf16*)(ws + WS_P))
#define MIXB ((bf16*)(ws + WS_MIX))
#define HB ((bf16*)(ws + WS_H))
    for (int u = F.tid; u < (LDS_BYTES - LDSCTL_OFF) / 4; u += NWAVES * 64) ((LAS unsigned*)(F.lds + LDSCTL_OFF))[u] = 0u;
    __syncthreads();
#if MK_PER_PHASE
#define GRID_BAR() do { } while (0)
#else
    XcdBarrier bar = xcd_barrier_post((unsigned*)(F.ctl + CW_BAR), F.MISC + 8);
#define GRID_BAR() xcd_barrier(bar)
#endif
    const int lo = args.ph_lo, hi = args.ph_hi;
#define IN(k) (lo <= (k) && (k) < hi)
#define SEAM(k) do { if (IN((k) + 1)) GRID_BAR(); } while (0)

    if (IN(0)) {
        ProIn I{args.in[1], args.in[3], args.in[4], args.in[5], args.in[7], args.in[12], args.in[14], args.in[15], args.in[6], args.in[13], args.in[8], args.in[9], args.in[10], args.in[11], args.in[16], MOD, (float*)(ws + WS_VEC), WIN_T, WOUT_T, W1_T, W2_T};
        p0_prologue(F, I);
        SEAM(0);
    }
    for (int l = 0; l < DEPTH; ++l) {
        const int pb = 1 + 7 * l;
        const bool last = l == DEPTH - 1;
        const float* mod_l = MOD + (size_t)l * 5 * MODW;
        const float* vec_l = VEC + (size_t)l * VEC_L;
        const float* xs_lat = l == 0 ? in_x : X;
        const float* xs_ctx = l == 0 ? in_ctx : X + (size_t)MLAT * DM;
#define OPAQUE_TID() do { int t_ = threadIdx.x; asm volatile("" : "+v"(t_)); F.tid = t_; F.lane = t_ & 63; F.wave = __builtin_amdgcn_readfirstlane(t_ >> 6); } while (0)
        if (IN(pb + 0)) { OPAQUE_TID(); norm_mod_phase(F, xs_lat, xs_ctx, vec_l + VEC_G1, mod_l, 0 * DM, 1 * DM, XN); SEAM(pb + 0); }
        if (IN(pb + 1)) { OPAQUE_TID();
            pg8::Gemm g{XN, WIN_T + (size_t)l * INC * DM, MT, INC, DM}; pg8::StaticOrder S; S.init(MT, INC, F.G, (int)blockIdx.x);
            pg8::EpiBf16<0> E{PB, INC};
            pg8::gemm_phase<pg8::EpiBf16<0>, pg8::StaticOrder, true, true>(F.lds + RING_OFF, g, S, E, F.tid);
            SEAM(pb + 1);
        }
        if (IN(pb + 2)) { OPAQUE_TID();
            mix::mixer_phase(F, PB, MIXB, vec_l + VEC_RPB, vec_l + VEC_CW, vec_l + VEC_GNA, vec_l + VEC_GCV, last ? 256 : 264);
            SEAM(pb + 2);
        }
        if (IN(pb + 3)) { OPAQUE_TID();
            pg8::Gemm g{MIXB, WOUT_T + (size_t)l * DM * DM, MT, DM, DM}; pg8::StaticOrder S; S.init(MT, DM, F.G, (int)blockIdx.x);
            pg8::EpiGateRes E{xs_lat, xs_ctx, X, mod_l + 2 * DM, DM, MODW};
            pg8::gemm_phase<pg8::EpiGateRes, pg8::StaticOrder, true, true>(F.lds + RING_OFF, g, S, E, F.tid);
            SEAM(pb + 3);
        }
        if (IN(pb + 4)) { OPAQUE_TID(); norm_mod_phase(F, X, X + (size_t)MLAT * DM, vec_l + VEC_G2, mod_l, 3 * DM, 4 * DM, XN); SEAM(pb + 4); }
        if (IN(pb + 5)) { OPAQUE_TID();
            pg8::Gemm g{XN, W1_T + (size_t)l * DFF * DM, MT, DFF, DM}; pg8::StaticOrder S; S.init(MT, DFF, F.G, (int)blockIdx.x);
            pg8::EpiBf16<2> E{HB, DFF};
            pg8::gemm_phase<pg8::EpiBf16<2>, pg8::StaticOrder, true, true>(F.lds + RING_OFF, g, S, E, F.tid);
            SEAM(pb + 5);
        }
        if (IN(pb + 6)) { OPAQUE_TID();
            pg8::Gemm g{HB, W2_T + (size_t)l * DM * DFF, MT, DM, DFF}; pg8::StaticOrder S; S.init(MT, DM, F.G, (int)blockIdx.x);
            pg8::EpiGateRes E{X, X + (size_t)MLAT * DM, X, mod_l + 5 * DM, DM, MODW};
            pg8::gemm_phase<pg8::EpiGateRes, pg8::StaticOrder, true, true>(F.lds + RING_OFF, g, S, E, F.tid);
            SEAM(pb + 6);
        }
    }
    if (IN(N_PHASES - 1)) final_norm_phase(F, X, VEC + VEC_GF, args.out);
#undef IN
#undef SEAM
}

extern "C" void kernel_launch(void* const* d_in, const int* in_sizes, int n_in, void* d_out, int out_size, void* d_ws, size_t ws_size, hipStream_t stream) {
    static int grid = 0;
    if (grid == 0) {
        if (n_in != 17 || in_sizes[0] != MLAT * DM || out_size != MLAT * DM || ws_size < WS_END) { fprintf(stderr, "kernel_launch: shape/workspace mismatch: n_in %d, in0 %d, out %d, ws %zu (need %zu); nothing launched\n", n_in, n_in > 0 ? in_sizes[0] : -1, out_size, ws_size, (size_t)WS_END); grid = -1; return; }
        int dev = 0, cus = 0, per_cu = 0;
        if (hipGetDevice(&dev) != hipSuccess || hipDeviceGetAttribute(&cus, hipDeviceAttributeMultiprocessorCount, dev) != hipSuccess) { fprintf(stderr, "kernel_launch: hipGetDevice / hipDeviceGetAttribute failed; nothing launched\n"); grid = -1; return; }
        if (hipFuncSetAttribute((const void*)skel_fwd, hipFuncAttributeMaxDynamicSharedMemorySize, LDS_BYTES) != hipSuccess) { fprintf(stderr, "kernel_launch: hipFuncSetAttribute failed; nothing launched\n"); grid = -1; return; }
        if (hipOccupancyMaxActiveBlocksPerMultiprocessor(&per_cu, (const void*)skel_fwd, NWAVES * 64, LDS_BYTES) != hipSuccess || per_cu < 1)
            fprintf(stderr, "kernel_launch: note: the occupancy query reports %d workgroups per CU\n", per_cu);
        (void)hipGetLastError();
        grid = cus;
    }
    if (grid < 0) return;
    if (hipMemsetAsync((char*)d_ws + WS_CTL, 0, CTL_ZERO_BYTES, stream) != hipSuccess) { fprintf(stderr, "kernel_launch: hipMemsetAsync of the control words failed; nothing launched\n"); return; }
    Args a{};
    for (int i = 0; i < 17; ++i) a.in[i] = (const float*)d_in[i];
    a.out = (float*)d_out; a.ws = (unsigned char*)d_ws;
#if MK_PER_PHASE
    for (int p = 0; p < N_PHASES; ++p) { a.ph_lo = p; a.ph_hi = p + 1; hipLaunchKernelGGL(skel_fwd, dim3(grid), dim3(NWAVES * 64), LDS_BYTES, stream, a); }
#else
    a.ph_lo = 0; a.ph_hi = N_PHASES;
    hipLaunchKernelGGL(skel_fwd, dim3(grid), dim3(NWAVES * 64), LDS_BYTES, stream, a);
#endif
    const hipError_t le = hipPeekAtLastError();
    if (le != hipSuccess) fprintf(stderr, "kernel_launch: launch failed: %s (grid %d x %d threads, %d B LDS)\n", hipGetErrorName(le), grid, NWAVES * 64, LDS_BYTES);
}
```

```cpp
#include <hip/hip_runtime.h>
#include <cstdio>
#include <cstdint>
namespace pg8 {
#define PG8_LAS __attribute__((address_space(3)))
typedef unsigned short bf16_t;
typedef short bf16x8 __attribute__((ext_vector_type(8)));
typedef float f32x4 __attribute__((ext_vector_type(4)));
typedef unsigned u32x4 __attribute__((ext_vector_type(4)));
constexpr int BM = 256, BK = 64, HALF = 128, HTB = HALF * BK * 2  , STAGE_BYTES = 8 * HTB, NXCD = 8;

__host__ __device__ __forceinline__ int lds_byte(int r, int c) { const int st = (r >> 4) * 2 + (c >> 5), rr = r & 15, cc = c & 31, ob = rr * 64 + cc * 2; return st * 1024 + (ob ^ (((ob >> 9) & 1) << 5)); }
__host__ __device__ __forceinline__ void stage_rc(int b, int& R, int& C) { const int st = b / 1024, sb = b % 1024, swz = sb ^ (((sb >> 9) & 1) << 5); R = (st >> 1) * 16 + swz / 64; C = (st & 1) * 32 + (swz % 64) / 2; }
__host__ __device__ __forceinline__ int perm32(int rho) { const int n = rho >> 4, i = rho & 15; return 8 * (i >> 2) + 4 * n + (i & 3); }

struct Unit { int pm, pn, k0, nt, ks; };
struct Gemm { const bf16_t* A; const bf16_t* Bt; int M, N, K; };

struct StaticOrder {
    int nM, nN, nwg, G, c, ntk, WGM;
    __host__ __device__ void init(int M, int N, int G_, int c_, int K, int wgm = 4) { nM = M / BM; nN = N / BM; nwg = nM * nN; G = G_; c = c_; ntk = K / BK; WGM = wgm; }
    __host__ __device__ __forceinline__ void tile_of(int wgid, int& pm, int& pn) const {
        { const int q = nwg / NXCD, r = nwg % NXCD, xcd = wgid % NXCD, off = wgid / NXCD; wgid = (xcd < r ? xcd * (q + 1) : r * (q + 1) + (xcd - r) * q) + off; }
        const int nig = WGM * nN, gid = wgid / nig, fm = gid * WGM, gsz = (nM - fm) < WGM ? (nM - fm) : WGM;
        pm = fm + ((wgid % nig) % gsz); pn = (wgid % nig) / gsz; }
    __host__ __device__ __forceinline__ bool next(int i, Unit& u) const {
        const long L = (long)i * G + c; const bool ok = L < nwg;
        int pm = 0, pn = 0; tile_of(ok ? (int)L : 0, pm, pn);
        u.pm = pm; u.pn = pn; u.k0 = 0; u.nt = ntk; u.ks = -1; return ok;
    }
    __device__ __forceinline__ void a_ready(const Unit&) const {}
    __device__ __forceinline__ void done(const Unit&) const {}
};
struct CtxColsOrder {
    StaticOrder lat; int NL, NC, nc, c0, ctx_pm0;
    __host__ __device__ void init(int M_lat, int N, int G_, int c_, int K, int ctx_pm0_, int c0_, int nc_, int wgm = 4) { lat.init(M_lat, N, G_, c_, K, wgm); NL = lat.nwg; ctx_pm0 = ctx_pm0_; c0 = c0_; nc = nc_; NC = 4 * nc_; }
    __host__ __device__ __forceinline__ bool next(int i, Unit& u) const {
        const long L = (long)i * lat.G + lat.c; const bool isl = L < NL; const long jl = L - NL; const bool isc = !isl && jl < NC;
        int pm = 0, pn = 0; lat.tile_of(isl ? (int)L : 0, pm, pn);
        if (isc) { const int j = (int)jl; pn = c0 + j % nc; pm = ctx_pm0 + j / nc; }
        u.pm = pm; u.pn = pn; u.k0 = 0; u.nt = lat.ntk; u.ks = -1; return isl || isc;
    }
    __device__ __forceinline__ void a_ready(const Unit&) const {}
    __device__ __forceinline__ void done(const Unit&) const {}
};
struct CtxSplitOrder {
    StaticOrder lat; int NL, NC, nN, ctx_pm0, kslice;
    __host__ __device__ void init(int M_lat, int N, int G_, int c_, int K, int nsplit  , int ctx_pm0_, int wgm = 4) {
        lat.init(M_lat, N, G_, c_, K, wgm); NL = lat.nwg; nN = N / BM; ctx_pm0 = ctx_pm0_; NC = nsplit ? 4 * nN * nsplit : 0; kslice = nsplit ? K / nsplit : K; }
    __host__ __device__ __forceinline__ bool next(int i, Unit& u) const {
        const long L = (long)i * lat.G + lat.c; const bool isl = L < NL; const long jl = L - NL; const bool isc = !isl && jl < NC;
        int pm = 0, pn = 0; lat.tile_of(isl ? (int)L : 0, pm, pn);
        int k0 = 0, nt = lat.ntk, ks = -1;
        if (isc) { const int j = (int)jl, nsp = NC / (4 * nN); ks = j % nsp; const int r = j / nsp; pn = r % nN; pm = ctx_pm0 + r / nN; k0 = ks * kslice; nt = kslice / BK; }
        u.pm = pm; u.pn = pn; u.k0 = k0; u.nt = nt; u.ks = ks; return isl || isc;
    }
    __device__ __forceinline__ void a_ready(const Unit&) const {}
    __device__ __forceinline__ void done(const Unit&) const {}
};

__device__ __forceinline__ float xsum16(float v) { const unsigned x = __builtin_bit_cast(unsigned, v); const auto r = __builtin_amdgcn_permlane16_swap(x, x, false, false); return __builtin_bit_cast(float, (unsigned)r[0]) + __builtin_bit_cast(float, (unsigned)r[1]); }
__device__ __forceinline__ float xsum32(float v) { const unsigned x = __builtin_bit_cast(unsigned, v); const auto r = __builtin_amdgcn_permlane32_swap(x, x, false, false); return __builtin_bit_cast(float, (unsigned)r[0]) + __builtin_bit_cast(float, (unsigned)r[1]); }
__device__ __forceinline__ unsigned cvt_pk_bf16(float lo, float hi) { unsigned r; asm volatile("v_cvt_pk_bf16_f32 %0, %1, %2" : "=v"(r) : "v"(lo), "v"(hi)); return r; }

template <int ACT  , bool PROD = false> struct EpiBf16 {
    static constexpr bool PERM = true, AFTER_DRAIN = false, MIDK = false;
    bf16_t* O; int ldc; const float* rstd; const float* bias; int bstride;
    int prod_pn0 = 1 << 30, prod_col0 = 0;
    __device__ __forceinline__ void operator()(const f32x4 (&acc)[2][2][4][2], const Unit& u, int wr, int wc, int fr, int fq) const {
        const int row0 = u.pm * BM + wr * 64 + fr; const int col0 = u.pn * BM + wc * 32 + 8 * fq;
        const float* bp = bias + (size_t)(u.pm < 128 ? (u.pm >> 5) : 4) * bstride + col0;
        f32x4 bv[2][2];
#pragma unroll
        for (int bj = 0; bj < 2; ++bj)
#pragma unroll
            for (int n = 0; n < 2; ++n) bv[bj][n] = *(const f32x4*)(bp + bj * HALF + 4 * n);
        float rv[2];
#pragma unroll
        for (int ai = 0; ai < 2; ++ai) rv[ai] = rstd[u.pm * BM + ai * HALF + wr * 64 + fr + 16 * fq];
        float rb[2][4];
#pragma unroll
        for (int ai = 0; ai < 2; ++ai) { const unsigned x = __builtin_bit_cast(unsigned, rv[ai]);
            const auto r16 = __builtin_amdgcn_permlane16_swap(x, x, false, false);
            const unsigned e = r16[0], o = r16[1];
            const auto pe = __builtin_amdgcn_permlane32_swap(e, e, false, false), po = __builtin_amdgcn_permlane32_swap(o, o, false, false);
            rb[ai][0] = __builtin_bit_cast(float, (unsigned)pe[0]); rb[ai][2] = __builtin_bit_cast(float, (unsigned)pe[1]);
            rb[ai][1] = __builtin_bit_cast(float, (unsigned)po[0]); rb[ai][3] = __builtin_bit_cast(float, (unsigned)po[1]); }
        const unsigned voff = (unsigned)(fr * ldc + 8 * fq) * 2u;
        if (PROD && u.pn >= prod_pn0) {
#pragma unroll
            for (int ai = 0; ai < 2; ++ai)
#pragma unroll
                for (int m = 0; m < 4; ++m) { bf16_t* rowp = (bf16_t*)((char*)(O + (size_t)(u.pm * BM + wr * 64 + ai * HALF + m * 16) * ldc + prod_col0 + 128 * (u.pn - prod_pn0) + wc * 32) + voff);
                    const float r = rb[ai][m];
                    const f32x4 p0 = (acc[ai][0][m][0] * r + bv[0][0]) * (acc[ai][1][m][0] * r + bv[1][0]), p1 = (acc[ai][0][m][1] * r + bv[0][1]) * (acc[ai][1][m][1] * r + bv[1][1]);
                    u32x4 w; w.x = cvt_pk_bf16(p0[0], p0[1]); w.y = cvt_pk_bf16(p0[2], p0[3]); w.z = cvt_pk_bf16(p1[0], p1[1]); w.w = cvt_pk_bf16(p1[2], p1[3]);
                    *(u32x4*)rowp = w; }
            return; }
#pragma unroll
        for (int ai = 0; ai < 2; ++ai)
#pragma unroll
            for (int m = 0; m < 4; ++m) { bf16_t* rowp = (bf16_t*)((char*)(O + (size_t)(u.pm * BM + wr * 64 + ai * HALF + m * 16) * ldc + u.pn * BM + wc * 32) + voff);
                const float r = rb[ai][m];
#pragma unroll
                for (int bj = 0; bj < 2; ++bj) { f32x4 v0 = acc[ai][bj][m][0] * r + bv[bj][0], v1 = acc[ai][bj][m][1] * r + bv[bj][1];
                    if (ACT == 2) {
#pragma unroll
                        for (int e = 0; e < 4; ++e) { const float a = fmaxf(v0[e], 0.f), b = fmaxf(v1[e], 0.f); v0[e] = a * a; v1[e] = b * b; } }
                    u32x4 w; w.x = cvt_pk_bf16(v0[0], v0[1]); w.y = cvt_pk_bf16(v0[2], v0[3]); w.z = cvt_pk_bf16(v1[0], v1[1]); w.w = cvt_pk_bf16(v1[2], v1[3]);
                    *(u32x4*)(rowp + bj * HALF) = w; } }
    }
};

struct EpiGateRes {
    static constexpr bool PERM = true, AFTER_DRAIN = false, MIDK = false;
    const float* base_f32; const bf16_t* base_bf; bf16_t* out; const float* gate; int ldc; int gstride;
    bf16_t* a2; float* ssq; int ssq_stride; const float* cs_g; const float* cs_sc;
    __device__ __forceinline__ void operator()(const f32x4 (&acc)[2][2][4][2], const Unit& u, int wr, int wc, int fr, int fq) const {
        const int col0 = u.pn * BM + wc * 32 + 8 * fq;
        const int mrow = u.pm >> 5;
        const float* gb = gate + (size_t)mrow * gstride + col0;
        const size_t roff = (size_t)(u.pm * BM + wr * 64 + fr) * ldc + col0;
        f32x4 gv[2][2], cv[2][2];
#pragma unroll
        for (int bj = 0; bj < 2; ++bj)
#pragma unroll
            for (int n = 0; n < 2; ++n) { gv[bj][n] = *(const f32x4*)(gb + bj * HALF + 4 * n);
                if (a2) cv[bj][n] = *(const f32x4*)(cs_g + col0 + bj * HALF + 4 * n) * (*(const f32x4*)(cs_sc + (size_t)mrow * gstride + col0 + bj * HALF + 4 * n) + 1.0f);
                else cv[bj][n] = (f32x4){0.f, 0.f, 0.f, 0.f}; }
#pragma unroll
        for (int gi = 0; gi < 8; ++gi) { const int ai = gi >> 2, m = gi & 3; const size_t off = (size_t)(ai * HALF + m * 16) * ldc;
            f32x4 bs[2][2];
            if (base_f32) {
#pragma unroll
                for (int bj = 0; bj < 2; ++bj)
#pragma unroll
                    for (int n = 0; n < 2; ++n) bs[bj][n] = *(const f32x4*)(base_f32 + roff + off + bj * HALF + 4 * n);
            } else {
#pragma unroll
                for (int bj = 0; bj < 2; ++bj) { const u32x4 r = *(const u32x4*)(base_bf + roff + off + bj * HALF);
                    bs[bj][0] = (f32x4){__uint_as_float(r.x << 16), __uint_as_float(r.x & 0xffff0000u), __uint_as_float(r.y << 16), __uint_as_float(r.y & 0xffff0000u)};
                    bs[bj][1] = (f32x4){__uint_as_float(r.z << 16), __uint_as_float(r.z & 0xffff0000u), __uint_as_float(r.w << 16), __uint_as_float(r.w & 0xffff0000u)}; }
            }
            float ss = 0.f;
#pragma unroll
            for (int bj = 0; bj < 2; ++bj) { f32x4 x[2];
#pragma unroll
                for (int n = 0; n < 2; ++n) { x[n] = bs[bj][n] + gv[bj][n] * acc[ai][bj][m][n];
                    ss += (x[n][0] * x[n][0] + x[n][1] * x[n][1]) + (x[n][2] * x[n][2] + x[n][3] * x[n][3]); }
                { u32x4 w; w.x = cvt_pk_bf16(x[0][0], x[0][1]); w.y = cvt_pk_bf16(x[0][2], x[0][3]); w.z = cvt_pk_bf16(x[1][0], x[1][1]); w.w = cvt_pk_bf16(x[1][2], x[1][3]);
                  *(u32x4*)(out + roff + off + bj * HALF) = w; }
                if (a2) { const f32x4 y0 = x[0] * cv[bj][0], y1 = x[1] * cv[bj][1];
                    u32x4 w; w.x = cvt_pk_bf16(y0[0], y0[1]); w.y = cvt_pk_bf16(y0[2], y0[3]); w.z = cvt_pk_bf16(y1[0], y1[1]); w.w = cvt_pk_bf16(y1[2], y1[3]);
                    *(u32x4*)(a2 + roff + off + bj * HALF) = w; } }
            if (a2) { ss = xsum16(ss); ss = xsum32(ss);
                if (fq == 0) ssq[(size_t)(u.pn * 4 + wc) * ssq_stride + u.pm * BM + wr * 64 + fr + ai * HALF + m * 16] = ss; }
            if (gi & 1) asm volatile("" ::: "memory"); }
    }
};
struct EpiGateResSplit {
    static constexpr bool PERM = true, AFTER_DRAIN = false, MIDK = false;
    EpiGateRes whole; float* part; int ctx_pm0; int ldc;
    __device__ __forceinline__ void operator()(const f32x4 (&acc)[2][2][4][2], const Unit& u, int wr, int wc, int fr, int fq) const {
        if (u.ks < 0) { whole(acc, u, wr, wc, fr, fq); return; }
        float* op = part + ((size_t)u.ks * 4 * BM + (size_t)(u.pm - ctx_pm0) * BM + wr * 64 + fr) * ldc + u.pn * BM + wc * 32 + 8 * fq;
#pragma unroll
        for (int ai = 0; ai < 2; ++ai)
#pragma unroll
            for (int m = 0; m < 4; ++m) { const size_t off = (size_t)(ai * HALF + m * 16) * ldc;
#pragma unroll
                for (int bj = 0; bj < 2; ++bj)
#pragma unroll
                    for (int n = 0; n < 2; ++n) *(f32x4*)(op + off + bj * HALF + 4 * n) = acc[ai][bj][m][n]; }
    }
};
struct EpiGateResSplitMid {
    static constexpr bool PERM = true, AFTER_DRAIN = false, MIDK = true;
    EpiGateResSplit base; const float* rna;
    __device__ __forceinline__ void operator()(const f32x4 (&acc)[2][2][4][2], const Unit& u, int wr, int wc, int fr, int fq) const { base(acc, u, wr, wc, fr, fq); }
    __device__ __forceinline__ void mid_load(float (&rv)[2], const Unit& u, int wr, int fr, int fq) const {
#pragma unroll
        for (int ai = 0; ai < 2; ++ai) rv[ai] = u.ks < 0 ? rna[u.pm * BM + ai * HALF + wr * 64 + fr + 16 * fq] : 1.0f; }
    __device__ __forceinline__ void mid(f32x4 (&acc)[2][2][4][2], const float (&rvv)[2]) const {
        float rb[2][4];
#pragma unroll
        for (int ai = 0; ai < 2; ++ai) { const unsigned x = __builtin_bit_cast(unsigned, rvv[ai]);
            const auto r16 = __builtin_amdgcn_permlane16_swap(x, x, false, false);
            const unsigned e = r16[0], o = r16[1];
            const auto pe = __builtin_amdgcn_permlane32_swap(e, e, false, false), po = __builtin_amdgcn_permlane32_swap(o, o, false, false);
            rb[ai][0] = __builtin_bit_cast(float, (unsigned)pe[0]); rb[ai][2] = __builtin_bit_cast(float, (unsigned)pe[1]);
            rb[ai][1] = __builtin_bit_cast(float, (unsigned)po[0]); rb[ai][3] = __builtin_bit_cast(float, (unsigned)po[1]); }
#pragma unroll
        for (int ai = 0; ai < 2; ++ai)
#pragma unroll
            for (int m = 0; m < 4; ++m)
#pragma unroll
                for (int bj = 0; bj < 2; ++bj)
#pragma unroll
                    for (int n = 0; n < 2; ++n) acc[ai][bj][m][n] = acc[ai][bj][m][n] * rb[ai][m];
    }
};

template <class Epi, class Sched, bool ALIGN_EPI = false, bool SP2 = false>
__device__ __forceinline__ void gemm_phase(PG8_LAS unsigned char* lds, const Gemm g, const Sched& S, const Epi& E, const int tid_in) {
    const int tid = tid_in, wid = __builtin_amdgcn_readfirstlane(tid >> 6), lane = tid & 63, wr = wid >> 2, wc = wid & 3, fr = lane & 15, fq = lane >> 4;
    const int K = g.K;
    unsigned voffA[2], voffB[2];
#pragma unroll
    for (int i = 0; i < 2; ++i) { int R, C; stage_rc(tid * 16 + i * 8192, R, C); const int Rb = Epi::PERM ? ((R & ~31) + perm32(R & 31)) : R;
        voffA[i] = (unsigned)(R * K + C) * 2u; voffB[i] = (unsigned)(Rb * K + C) * 2u; }
    const size_t kstep = (size_t)(BK * 2);
    const size_t hstep = (size_t)HALF * K * 2;
    const size_t tstep = 2 * hstep;
    const unsigned ldsw = (unsigned)wid * 1024u;
    const int aoff = lds_byte(wr * 64 + fr, fq * 8), boff = lds_byte(wc * 32 + fr, fq * 8);
#define PG8_SA(b, h) (((b) * 2 + (h)) * HTB)
#define PG8_SB(b, h) ((4 + (b) * 2 + (h)) * HTB)
#define PG8_STAGE(bufoff, gbase, voff) do { _Pragma("unroll") for (int _i = 0; _i < 2; ++_i) \
        __builtin_amdgcn_global_load_lds((const unsigned*)((const char*)(gbase) + (voff)[_i]), (PG8_LAS unsigned*)(lds + (bufoff) + ldsw + _i * 8192), 16, 0, 0); } while (0)
#define PG8_LDA(dst, b, h) do { _Pragma("unroll") for (int m = 0; m < 4; ++m) _Pragma("unroll") for (int k = 0; k < 2; ++k) dst[m][k] = *(const PG8_LAS bf16x8*)(lds + PG8_SA(b, h) + aoff + m * 2048 + k * 1024); } while (0)
#define PG8_LDB(dst, b, h) do { _Pragma("unroll") for (int n = 0; n < 2; ++n) _Pragma("unroll") for (int k = 0; k < 2; ++k) dst[n][k] = *(const PG8_LAS bf16x8*)(lds + PG8_SB(b, h) + boff + n * 2048 + k * 1024); } while (0)
#define PG8_MMA(ai, bj, At, Bt) do { __builtin_amdgcn_s_setprio(1); _Pragma("unroll") for (int m = 0; m < 4; ++m) _Pragma("unroll") for (int n = 0; n < 2; ++n) _Pragma("unroll") for (int k = 0; k < 2; ++k) \
        acc[ai][bj][m][n] = __builtin_amdgcn_mfma_f32_16x16x32_bf16(Bt[n][k], At[m][k], acc[ai][bj][m][n], 0, 0, 0); __builtin_amdgcn_s_setprio(0); } while (0)
#define PG8_WAIT_V(n) asm volatile("s_waitcnt vmcnt(" #n ")" ::: "memory")
#define PG8_WAIT_L(n) asm volatile("s_waitcnt lgkmcnt(" #n ")" ::: "memory")
#define PG8_BAR __builtin_amdgcn_s_barrier()
#define PG8_SCHED __builtin_amdgcn_sched_barrier(0)
    Unit cur, nxt; int ui = 0;
    if (!S.next(0, cur)) return;
    f32x4 acc[2][2][4][2];
#pragma unroll
    for (int a = 0; a < 2; ++a)
#pragma unroll
        for (int b = 0; b < 2; ++b)
#pragma unroll
            for (int m = 0; m < 4; ++m)
#pragma unroll
                for (int n = 0; n < 2; ++n) acc[a][b][m][n] = (f32x4){0.f, 0.f, 0.f, 0.f};
    bf16x8 At[4][2], B0[2][2], B1[2][2];
    const char* cA = (const char*)g.A + (size_t)cur.pm * tstep + (size_t)cur.k0 * 2; const char* cB = (const char*)g.Bt + (size_t)cur.pn * tstep + (size_t)cur.k0 * 2;
    S.a_ready(cur);
    if constexpr (SP2) {
        PG8_STAGE(PG8_SB(0, 0), cB, voffB); PG8_STAGE(PG8_SB(0, 1), cB + hstep, voffB); PG8_STAGE(PG8_SA(0, 0), cA, voffA); PG8_STAGE(PG8_SA(0, 1), cA + hstep, voffA);
        if (wr == 1) PG8_BAR;
        PG8_WAIT_V(2); PG8_BAR;
        PG8_STAGE(PG8_SB(1, 0), cB + kstep, voffB); PG8_STAGE(PG8_SA(1, 0), cA + kstep, voffA); PG8_STAGE(PG8_SB(1, 1), cB + hstep + kstep, voffB);
        PG8_WAIT_V(6); PG8_BAR;
    } else {
        PG8_STAGE(PG8_SB(0, 0), cB, voffB); PG8_STAGE(PG8_SA(0, 0), cA, voffA); PG8_STAGE(PG8_SB(0, 1), cB + hstep, voffB); PG8_STAGE(PG8_SA(0, 1), cA + hstep, voffA);
        if (wr == 1) PG8_BAR;
        PG8_WAIT_V(4); PG8_BAR;
        PG8_STAGE(PG8_SB(1, 0), cB + kstep, voffB); PG8_STAGE(PG8_SA(1, 0), cA + kstep, voffA); PG8_STAGE(PG8_SB(1, 1), cB + hstep + kstep, voffB);
        PG8_WAIT_V(6); PG8_BAR;
    }
    for (;;) {
        const bool has_next = S.next(ui + 1, nxt);
        const char* nA = has_next ? (const char*)g.A + (size_t)nxt.pm * tstep + (size_t)nxt.k0 * 2 : cA; const char* nB = has_next ? (const char*)g.Bt + (size_t)nxt.pn * tstep + (size_t)nxt.k0 * 2 : cB;
        const int nt = cur.nt;
        const int npass = Epi::MIDK ? 2 : 1;
        float mrv[2] = {1.0f, 1.0f};
        if constexpr (Epi::MIDK) E.mid_load(mrv, cur, wr, fr, fq);
#pragma unroll 1
        for (int ps = 0; ps < npass; ++ps) {
        const int t_lo = (Epi::MIDK && ps == 1) ? nt / 2 : 0, t_hi = (Epi::MIDK && ps == 0) ? nt / 2 : nt;
        for (int t = t_lo; t < t_hi; t += 2) {
            const bool last = (t == nt - 2);
            const char* a1 = cA + (size_t)(t + 1) * kstep;
            const char* a2 = last ? nA : cA + (size_t)(t + 2) * kstep; const char* b2 = last ? nB : cB + (size_t)(t + 2) * kstep;
            const char* a3 = a2 + kstep; const char* b3 = b2 + kstep;
            if (last && has_next) S.a_ready(nxt);
            if constexpr (SP2) {
            PG8_LDB(B0, 0, 0); PG8_LDB(B1, 0, 1); PG8_SCHED; PG8_LDA(At, 0, 0); PG8_STAGE(PG8_SA(1, 1), a1 + hstep, voffA);
            PG8_WAIT_V(8); PG8_WAIT_L(0); PG8_BAR; PG8_MMA(0, 0, At, B0); PG8_MMA(0, 1, At, B1); PG8_BAR; PG8_SCHED;
            PG8_LDA(At, 0, 1); PG8_STAGE(PG8_SB(0, 0), b2, voffB); PG8_STAGE(PG8_SB(0, 1), b2 + hstep, voffB); PG8_STAGE(PG8_SA(0, 0), a2, voffA);
            PG8_WAIT_V(8); PG8_WAIT_L(0); PG8_BAR; PG8_MMA(1, 0, At, B0); PG8_MMA(1, 1, At, B1); PG8_BAR; PG8_SCHED;
            PG8_LDB(B0, 1, 0); PG8_LDB(B1, 1, 1); PG8_SCHED; PG8_LDA(At, 1, 0); PG8_STAGE(PG8_SA(0, 1), a2 + hstep, voffA);
            PG8_WAIT_V(8); PG8_WAIT_L(0); PG8_BAR; PG8_MMA(0, 0, At, B0); PG8_MMA(0, 1, At, B1); PG8_BAR; PG8_SCHED;
            PG8_LDA(At, 1, 1); PG8_STAGE(PG8_SB(1, 0), b3, voffB); PG8_STAGE(PG8_SB(1, 1), b3 + hstep, voffB); PG8_STAGE(PG8_SA(1, 0), a3, voffA);
            PG8_WAIT_V(8); PG8_WAIT_L(0); PG8_BAR; PG8_MMA(1, 0, At, B0); PG8_MMA(1, 1, At, B1); PG8_BAR; PG8_SCHED;
            } else {
            PG8_LDB(B0, 0, 0); PG8_SCHED; PG8_LDA(At, 0, 0); PG8_STAGE(PG8_SA(1, 1), a1 + hstep, voffA);
            PG8_WAIT_L(8); PG8_BAR; PG8_WAIT_L(0); PG8_MMA(0, 0, At, B0); PG8_BAR; PG8_SCHED;
            PG8_LDB(B1, 0, 1); PG8_STAGE(PG8_SB(0, 0), b2, voffB);
            PG8_BAR; PG8_WAIT_L(0); PG8_MMA(0, 1, At, B1); PG8_BAR;
            PG8_LDA(At, 0, 1); PG8_STAGE(PG8_SA(0, 0), a2, voffA);
            PG8_BAR; PG8_WAIT_L(0); PG8_MMA(1, 0, At, B0); PG8_BAR; PG8_SCHED;
            PG8_STAGE(PG8_SB(0, 1), b2 + hstep, voffB);
            PG8_WAIT_V(6); PG8_BAR; PG8_MMA(1, 1, At, B1); PG8_BAR;
            PG8_LDB(B0, 1, 0); PG8_SCHED; PG8_LDA(At, 1, 0); PG8_STAGE(PG8_SA(0, 1), a2 + hstep, voffA);
            PG8_WAIT_L(8); PG8_BAR; PG8_WAIT_L(0); PG8_MMA(0, 0, At, B0); PG8_BAR; PG8_SCHED;
            PG8_LDB(B1, 1, 1); PG8_STAGE(PG8_SB(1, 0), b3, voffB);
            PG8_BAR; PG8_WAIT_L(0); PG8_MMA(0, 1, At, B1); PG8_BAR;
            PG8_LDA(At, 1, 1); PG8_STAGE(PG8_SA(1, 0), a3, voffA);
            PG8_BAR; PG8_WAIT_L(0); PG8_MMA(1, 0, At, B0); PG8_BAR; PG8_SCHED;
            PG8_STAGE(PG8_SB(1, 1), b3 + hstep, voffB);
            PG8_WAIT_V(6); PG8_BAR; PG8_MMA(1, 1, At, B1); PG8_BAR;
            }
        }
        if constexpr (Epi::MIDK) { if (ps == 0) E.mid(acc, mrv); }
        }
        if constexpr (ALIGN_EPI) { if (wr == 0) PG8_BAR; }
        if constexpr (!Epi::AFTER_DRAIN) { E(acc, cur, wr, wc, fr, fq); S.done(cur); }
        if (!has_next) break;
#pragma unroll
        for (int a = 0; a < 2; ++a)
#pragma unroll
            for (int b = 0; b < 2; ++b)
#pragma unroll
                for (int m = 0; m < 4; ++m)
#pragma unroll
                    for (int n = 0; n < 2; ++n) acc[a][b][m][n] = (f32x4){0.f, 0.f, 0.f, 0.f};
        cur = nxt; cA = nA; cB = nB; ++ui;
        if constexpr (ALIGN_EPI) { if (wr == 1) PG8_BAR; }
    }
    PG8_WAIT_V(0);
    if constexpr (!ALIGN_EPI) { if (wr == 0) PG8_BAR; }
    PG8_BAR;
    if constexpr (Epi::AFTER_DRAIN) { E.fused(acc, cur, wr, wc, fr, fq, lds, wid, lane); S.done(cur); }
#undef PG8_SA
#undef PG8_SB
#undef PG8_STAGE
#undef PG8_LDA
#undef PG8_LDB
#undef PG8_MMA
#undef PG8_WAIT_V
#undef PG8_WAIT_L
#undef PG8_BAR
#undef PG8_SCHED
}
}

constexpr int NWAVES = 8;
#ifndef MK_PER_PHASE
#define MK_PER_PHASE 0
#endif

constexpr int DM = 2048, NB = 4, SEQ = 8192, DEPTH = 4, CTXL = 256, GRID_W = 64, GRID_R = SEQ / GRID_W;
constexpr int NAW = 1024, NH = 8, HD = 128, CVW = 1024, INC = 6144, DFF = 8192, NMOD = 6, MODW = NMOD * DM;
constexpr int WIN_R = 8, WIN_C = 16, RPB_R = 2 * WIN_R - 1, RPB_C = 2 * WIN_C - 1, RPB_HS = RPB_R * RPB_C;
constexpr int MLAT = NB * SEQ, MCTX = NB * CTXL, MT = MLAT + MCTX;
constexpr float EPS = 1e-6f;
constexpr int COL_Q = 0, COL_K = NAW, COL_V = 2 * NAW, COL_BG = 3 * NAW, COL_CG = 3 * NAW + CVW, COL_U = 3 * NAW + 2 * CVW;
constexpr int PPITCH = INC + 64;
constexpr int N_PHASES = 2 + 7 * DEPTH;

constexpr size_t MiB = 1u << 20;
constexpr size_t WS_CTL = 0, CTL_ZERO_BYTES = 1 * MiB;
constexpr size_t WS_MOD = 1 * MiB;
constexpr size_t WS_VEC = 2 * MiB;
constexpr size_t WS_WIN = 3 * MiB, WS_WOUT = 99 * MiB, WS_W1 = 131 * MiB, WS_W2 = 259 * MiB;
constexpr size_t WS_X = 387 * MiB;
constexpr size_t WS_XN = 651 * MiB;
constexpr size_t WS_P = 783 * MiB;
constexpr size_t WS_MIX = 1184 * MiB;
constexpr size_t WS_H = 783 * MiB;
constexpr size_t WS_PO = 1316 * MiB, WS_PM = 1380 * MiB;
constexpr size_t WS_SSQ = 1444 * MiB, SSQ_BYTES = 2 * MiB;
constexpr size_t WS_SHW = 1446 * MiB;
constexpr size_t WS_SSQP = 1448 * MiB;
constexpr size_t WS_END = 1454 * MiB;
constexpr int NSPLIT = 8;
constexpr int VEC_G1 = 0, VEC_G2 = DM, VEC_RPB = 2 * DM, VEC_CW = VEC_RPB + 3728, VEC_GNA = VEC_CW + 3 * CVW, VEC_GCV = VEC_GNA + NAW, VEC_L = VEC_GCV + CVW, VEC_GF = DEPTH * VEC_L;
static_assert(NH * RPB_HS <= 3728 && (size_t)(VEC_GF + DM) * 4 <= MiB && VEC_CW % 4 == 0 && VEC_L % 4 == 0, "VEC map");
static_assert((size_t)DEPTH * 5 * MODW * 4 <= MiB && WS_WIN + (size_t)DEPTH * INC * DM * 2 <= WS_WOUT && WS_WOUT + (size_t)DEPTH * DM * DM * 2 <= WS_W1 && WS_W1 + (size_t)DEPTH * DFF * DM * 2 <= WS_W2 &&
              WS_W2 + (size_t)DEPTH * DFF * DM * 2 <= WS_X && WS_X + (size_t)MT * DM * 4 <= WS_XN && WS_XN + (size_t)MT * DM * 2 <= WS_P && WS_P + (size_t)MT * PPITCH * 2 <= WS_MIX &&
              WS_MIX + (size_t)MT * DM * 2 <= WS_PO && WS_H + (size_t)MT * DFF * 2 <= WS_PO && WS_PO + (size_t)NSPLIT * MCTX * DM * 4 <= WS_PM && WS_PM + (size_t)NSPLIT * MCTX * DM * 4 <= WS_SSQ && (size_t)DEPTH * 2 * MT * 4 <= SSQ_BYTES && WS_SHW + (size_t)DEPTH * 5 * (INC + DFF) * 4 <= WS_SSQP && WS_SSQP + (size_t)32 * MT * 4 <= WS_END, "d_ws map");
constexpr int CW_BAR = 4096;

constexpr int RING_OFF = 0, RING_BYTES = 131072;
constexpr int LDSCTL_OFF = RING_BYTES, MISC_OFF = LDSCTL_OFF + 320;
constexpr int LDS_BYTES = 147456;
static_assert(MISC_OFF + 128 <= LDS_BYTES, "LDS map");

#define GAS __attribute__((address_space(1)))
#define LAS __attribute__((address_space(3)))
typedef unsigned short bf16;
typedef unsigned v4u __attribute__((ext_vector_type(4)));
typedef float f32x4 __attribute__((ext_vector_type(4)));
typedef short bf16x8 __attribute__((ext_vector_type(8)));
typedef GAS unsigned gu32;
typedef GAS unsigned long long gu64;
#define RLX_AGENT __ATOMIC_RELAXED, __HIP_MEMORY_SCOPE_AGENT
#define LDS_WAIT() asm volatile("s_waitcnt lgkmcnt(0)" ::: "memory")
#define VM_WAIT() asm volatile("s_waitcnt vmcnt(0)" ::: "memory")
__device__ __forceinline__ unsigned long long rt() { return __builtin_amdgcn_s_memrealtime(); }
__device__ __forceinline__ unsigned f2bf(float f) { unsigned u = __builtin_bit_cast(unsigned, f); return (u + 0x7fffu + ((u >> 16) & 1u)) >> 16; }
__device__ __forceinline__ unsigned pk2(float lo, float hi) { return f2bf(lo) | (f2bf(hi) << 16); }

#define XB_TMO      128
#define XB_XCNT(j)  (256  + 64 * (j))
#define XB_XSUB(j)  (1280 + 64 * (j))
#define XB_XGEN(j)  (2304 + 64 * (j))
#define XB_TOP      3328
#define XB_TOPGEN   3392
#define XCD_BAR_WORDS 3456
#define XB_SPIN_CAP (1u << 18)

__device__ __forceinline__ unsigned xb_ld(unsigned* p)              { return __hip_atomic_load(p, __ATOMIC_RELAXED, __HIP_MEMORY_SCOPE_AGENT); }
__device__ __forceinline__ unsigned xb_add(unsigned* p, unsigned v) { return __hip_atomic_fetch_add(p, v, __ATOMIC_RELAXED, __HIP_MEMORY_SCOPE_AGENT); }
__device__ __forceinline__ unsigned xb_xcc_id() { return (unsigned)__builtin_amdgcn_s_getreg((3 << 11) | 20) & 0xFu; }
#define XB_SPIN(cond, bar) do { unsigned _sp = 0; while (cond) { __builtin_amdgcn_s_sleep(1); \
    if ((++_sp & 255u) == 0u) { if (xb_ld(&(bar)[XB_TMO])) break; if (_sp > XB_SPIN_CAP) { atomicAdd(&(bar)[XB_TMO], 1u); break; } } } } while (0)

struct XcdBarrier {
    unsigned* bar; unsigned x;
    volatile LAS unsigned* st;
};

__device__ __forceinline__ XcdBarrier xcd_barrier_post(unsigned* bar, volatile LAS unsigned* st) {
    XcdBarrier b; b.bar = bar; b.x = xb_xcc_id(); b.st = st;
    if (threadIdx.x == 0) (void)xb_add(&bar[XB_XCNT(b.x)], 1u);
    return b;
}
__device__ __forceinline__ void xcd_barrier_complete(unsigned* bar, unsigned x, unsigned& nloc, unsigned& nx) {
    const unsigned G = gridDim.x * gridDim.y * gridDim.z;
    unsigned sum, cnt, mine, sp = 0u;
    for (;;) {
        sum = 0u; cnt = 0u; mine = 0u;
#pragma unroll
        for (unsigned j = 0; j < 16; ++j) { const unsigned c = xb_ld(&bar[XB_XCNT(j)]); sum += c; cnt += (c > 0u) ? 1u : 0u; mine = (j == x) ? c : mine; }
        if (sum == G) break;
        __builtin_amdgcn_s_sleep(1);
        if ((++sp & 255u) == 0u) { if (xb_ld(&bar[XB_TMO])) break; if (sp > XB_SPIN_CAP) { atomicAdd(&bar[XB_TMO], 1u); break; } }
    }
    nloc = mine > 0u ? mine : 1u; nx = cnt > 0u ? cnt : 1u;
}

__device__ __forceinline__ void xcd_barrier(const XcdBarrier& b) {
    asm volatile("s_waitcnt vmcnt(0)" ::: "memory");
    __syncthreads();
    if (threadIdx.x == 0) {
        unsigned* bar = b.bar;
        __builtin_amdgcn_s_waitcnt(0);
        unsigned nloc = b.st[0], nx = b.st[1];
        if (nloc == 0u) { xcd_barrier_complete(bar, b.x, nloc, nx); b.st[0] = nloc; b.st[1] = nx; }
        const unsigned old = xb_add(&bar[XB_XSUB(b.x)], 1u);
        const unsigned gen = old / nloc;
        if (old + 1u == (gen + 1u) * nloc) {
            __builtin_amdgcn_fence(__ATOMIC_RELEASE, "agent");
            asm volatile("s_waitcnt vmcnt(0)" ::: "memory");
            const unsigned og = xb_add(&bar[XB_TOP], 1u);
            const unsigned tg = og / nx;
            if (og + 1u == (tg + 1u) * nx) xb_add(&bar[XB_TOPGEN], 1u);
            else XB_SPIN(xb_ld(&bar[XB_TOPGEN]) == tg, bar);
            __builtin_amdgcn_fence(__ATOMIC_ACQUIRE, "agent");
            xb_add(&bar[XB_XGEN(b.x)], 1u);
            asm volatile("s_waitcnt vmcnt(0)" ::: "memory");
        } else {
            XB_SPIN(xb_ld(&bar[XB_XGEN(b.x)]) == gen, bar);
            __builtin_amdgcn_fence(__ATOMIC_ACQUIRE, "agent");
            asm volatile("s_waitcnt vmcnt(0)" ::: "memory");
        }
    }
    __syncthreads();
}

struct Frame {
    LAS unsigned char* lds;
    volatile LAS unsigned* MISC;
    gu32* ctl;
    int tid, lane, wave;
    int vcu, G;
};
typedef unsigned u32x2 __attribute__((ext_vector_type(2)));
typedef short v4i16_t __attribute__((ext_vector_type(4)));
typedef float f32x4v __attribute__((ext_vector_type(4)));

template <int CTRL> __device__ __forceinline__ float dpp_mov(float v) { return __uint_as_float(__builtin_amdgcn_update_dpp(0u, __float_as_uint(v), CTRL, 0xF, 0xF, true)); }
__device__ __forceinline__ float x16_sum(float v) { const unsigned x = __float_as_uint(v); const auto r = __builtin_amdgcn_permlane16_swap(x, x, false, false); return __uint_as_float(r[0]) + __uint_as_float(r[1]); }
__device__ __forceinline__ float x32_sum(float v) { const unsigned x = __float_as_uint(v); const auto r = __builtin_amdgcn_permlane32_swap(x, x, false, false); return __uint_as_float(r[0]) + __uint_as_float(r[1]); }
__device__ __forceinline__ float x16_max(float v) { const unsigned x = __float_as_uint(v); const auto r = __builtin_amdgcn_permlane16_swap(x, x, false, false); return fmaxf(__uint_as_float(r[0]), __uint_as_float(r[1])); }
__device__ __forceinline__ float x32_max(float v) { const unsigned x = __float_as_uint(v); const auto r = __builtin_amdgcn_permlane32_swap(x, x, false, false); return fmaxf(__uint_as_float(r[0]), __uint_as_float(r[1])); }
__device__ __forceinline__ float wave_sum(float v) {
    v += dpp_mov<0xB1>(v);
    v += dpp_mov<0x4E>(v);
    v += dpp_mov<0x141>(v);
    v += dpp_mov<0x140>(v);
    return x32_sum(x16_sum(v));
}
__device__ __forceinline__ float bf_lo(unsigned w) { return __uint_as_float(w << 16); }
__device__ __forceinline__ float bf_hi(unsigned w) { return __uint_as_float(w & 0xffff0000u); }

__device__ __forceinline__ void p0_transpose_item(const float* W, int K, int N, bf16* WT, LAS float* scr, int item, int lane, bool cgu = false, const float* kscale = nullptr) {
    const int nblk = N / 32, kb = item / nblk, nb = item % nblk, k0 = 64 * kb, n0 = 32 * nb;
    int s0 = n0;
    if (cgu && n0 >= COL_CG) { const int t = (n0 - COL_CG) >> 8, c = (n0 - COL_CG) & 255; s0 = c < 128 ? COL_CG + 128 * t + c : COL_U + 128 * t + (c - 128); }
    float wv[32];
#pragma unroll
    for (int i = 0; i < 32; ++i) { const int kk = 2 * i + (lane >> 5); wv[i] = W[(size_t)(k0 + kk) * N + s0 + (lane & 31)]; if (kscale && k0 < NAW) wv[i] *= kscale[k0 + kk]; }
#pragma unroll
    for (int i = 0; i < 32; ++i) { const int kk = 2 * i + (lane >> 5); scr[kk * 33 + (lane & 31)] = wv[i]; }
    LDS_WAIT(); asm volatile("" ::: "memory");
    const int c = lane & 7;
#pragma unroll
    for (int j = 0; j < 4; ++j) { const int n = (lane >> 3) + 8 * j; const LAS float* s = scr + (8 * c) * 33 + n;
        v4u o; o.x = pk2(s[0 * 33], s[1 * 33]); o.y = pk2(s[2 * 33], s[3 * 33]); o.z = pk2(s[4 * 33], s[5 * 33]); o.w = pk2(s[6 * 33], s[7 * 33]);
        *(GAS v4u*)(WT + (size_t)(n0 + n) * K + k0 + 8 * c) = o; }
    LDS_WAIT(); asm volatile("" ::: "memory");
}
struct ProIn { const float *c, *c_ctx, *w_ada, *b_ada, *w_in, *w_out, *w1, *w2, *g1, *g2, *rpb, *cw, *gna, *gcv, *gf; float* mod; float* vec; bf16 *win_t, *wout_t, *w1_t, *w2_t; };
__device__ __forceinline__ void p0_prologue(Frame& F, const ProIn& I) {
    LAS float* S = (LAS float*)(F.lds + RING_OFF);
    LAS float* RED = S + 5 * DM;
    for (int i = F.tid; i < 5 * DM; i += NWAVES * 64) { const int r = i / DM, k = i % DM; const float v = r < 4 ? I.c[r * DM + k] : I.c_ctx[k]; S[i] = v / (1.0f + __expf(-v)); }
    __syncthreads();
    constexpr int NSLAB = DEPTH * (MODW / 64);
    for (int slab = blockIdx.x; slab < NSLAB; slab += F.G) {
        const int l = slab / (MODW / 64), n0 = (slab % (MODW / 64)) * 64;
        const float* wp = I.w_ada + (size_t)l * DM * MODW + (size_t)(F.wave * 256) * MODW + n0 + F.lane;
        float a0 = 0.f, a1 = 0.f, a2 = 0.f, a3 = 0.f, a4 = 0.f;
        const LAS float* s0 = S + F.wave * 256;
#pragma unroll 32
        for (int k = 0; k < 256; ++k) { const float w = wp[(size_t)k * MODW];
            a0 += s0[k] * w; a1 += s0[DM + k] * w; a2 += s0[2 * DM + k] * w; a3 += s0[3 * DM + k] * w; a4 += s0[4 * DM + k] * w; }
        LAS float* rd = RED + F.wave * 320 + F.lane;
        rd[0] = a0; rd[64] = a1; rd[128] = a2; rd[192] = a3; rd[256] = a4;
        __syncthreads();
        if (F.tid < 320) { float s = 0.f;
#pragma unroll
            for (int w = 0; w < 8; ++w) s += RED[w * 320 + F.tid];
            const int r = F.tid >> 6, n = n0 + (F.tid & 63);
            I.mod[((size_t)l * 5 + r) * MODW + n] = s + I.b_ada[(size_t)l * MODW + n]; }
        __syncthreads();
    }
    __syncthreads();
    { const int gt = blockIdx.x * (NWAVES * 64) + F.tid, NGT = F.G * NWAVES * 64;
      for (int i = gt; i < DEPTH * VEC_L + DM; i += NGT) {
          float v;
          if (i >= VEC_GF) v = I.gf[i - VEC_GF];
          else { const int l = i / VEC_L, r = i % VEC_L;
              if (r < VEC_G2) v = I.g1[l * DM + r];
              else if (r < VEC_RPB) v = I.g2[l * DM + r - VEC_G2];
              else if (r < VEC_CW) v = (r - VEC_RPB) < NH * RPB_HS ? I.rpb[l * NH * RPB_HS + r - VEC_RPB] : 0.f;
              else if (r < VEC_GNA) v = I.cw[l * 3 * CVW + r - VEC_CW];
              else if (r < VEC_GCV) v = I.gna[l * NAW + r - VEC_GNA];
              else v = I.gcv[l * CVW + r - VEC_GCV]; }
          I.vec[i] = v; } }
    LAS float* scr = (LAS float*)(F.lds + RING_OFF + F.wave * 16384);
    const int gw = F.vcu * NWAVES + F.wave, NGW = F.G * NWAVES;
    constexpr int I_IN = (DM / 64) * (INC / 32), I_OUT = (DM / 64) * (DM / 32), I_1 = (DM / 64) * (DFF / 32), I_2 = (DFF / 64) * (DM / 32);
    constexpr int I_L = I_IN + I_OUT + I_1 + I_2, NITEMS = DEPTH * I_L;
    for (int it = gw; it < NITEMS; it += NGW) {
        const int l = it / I_L; int r = it % I_L;
        if (r < I_IN) { p0_transpose_item(I.w_in + (size_t)l * DM * INC, DM, INC, I.win_t + (size_t)l * INC * DM, scr, r, F.lane, true); continue; } r -= I_IN;
        if (r < I_OUT) { p0_transpose_item(I.w_out + (size_t)l * DM * DM, DM, DM, I.wout_t + (size_t)l * DM * DM, scr, r, F.lane, false, I.gna + (size_t)l * NAW); continue; } r -= I_OUT;
        if (r < I_1) { p0_transpose_item(I.w1 + (size_t)l * DM * DFF, DM, DFF, I.w1_t + (size_t)l * DFF * DM, scr, r, F.lane); continue; } r -= I_1;
        p0_transpose_item(I.w2 + (size_t)l * DFF * DM, DFF, DM, I.w2_t + (size_t)l * DM * DFF, scr, r, F.lane);
    }
}

__device__ __forceinline__ void norm_prep_phase(Frame& F, const float* src_lat, const float* src_ctx, const bf16* src_ctx_bf, const float* g, const float* sc_base, bf16* A2, float* ssq, int row_lo, int nrows,
                                                const float* part, const float* gate_ctx, bf16* ctx_out, const float* ssqh) {
    const int gw = F.vcu * NWAVES + F.wave, NGW = F.G * NWAVES;
    for (int row = row_lo + gw; row < nrows; row += NGW) {
        const bool lat = row < MLAT;
        const float* sc = sc_base + (size_t)(lat ? (row >> 13) : 4) * MODW;
        f32x4v v[8]; float ss = 0.f;
        if (lat || src_ctx) { const float* xr = lat ? src_lat + (size_t)row * DM : src_ctx + (size_t)(row - MLAT) * DM;
#pragma unroll
            for (int j = 0; j < 8; ++j) v[j] = *(const f32x4v*)(xr + 256 * j + 4 * F.lane); }
        else { const bf16* xb = src_ctx_bf + (size_t)(row - MLAT) * DM;
#pragma unroll
            for (int j = 0; j < 8; ++j) { const u32x2 r = *(const u32x2*)(xb + 256 * j + 4 * F.lane); v[j] = (f32x4v){bf_lo(r.x), bf_hi(r.x), bf_lo(r.y), bf_hi(r.y)}; } }
        if (!lat && part) {
            const float* pr = part + (size_t)(row - MLAT) * DM + 4 * F.lane;
            float na_scale = 1.0f;
            if (ssqh) { const float* sp = ssqh + (size_t)(row - MLAT) * NH; float t = 0.f;
#pragma unroll
                for (int hh = 0; hh < NH; ++hh) t += sp[hh];
                na_scale = rsqrtf(t * (1.0f / NAW) + EPS); }
#pragma unroll
            for (int j = 0; j < 8; ++j) { f32x4v a = *(const f32x4v*)(pr + 256 * j);
#pragma unroll
                for (int s = 1; s < NSPLIT / 2; ++s) a += *(const f32x4v*)(pr + (size_t)s * MCTX * DM + 256 * j);
                a = a * na_scale;
#pragma unroll
                for (int s = NSPLIT / 2; s < NSPLIT; ++s) a += *(const f32x4v*)(pr + (size_t)s * MCTX * DM + 256 * j);
                v[j] += *(const f32x4v*)(gate_ctx + 256 * j + 4 * F.lane) * a;
                { u32x2 o; o.x = pk2(v[j].x, v[j].y); o.y = pk2(v[j].z, v[j].w); *(u32x2*)(ctx_out + (size_t)(row - MLAT) * DM + 256 * j + 4 * F.lane) = o; } }
        }
#pragma unroll
        for (int j = 0; j < 8; ++j) { ss += (v[j].x * v[j].x + v[j].y * v[j].y) + (v[j].z * v[j].z + v[j].w * v[j].w);
            const int c = 256 * j + 4 * F.lane;
            const f32x4v y = v[j] * (*(const f32x4v*)(g + c)) * (*(const f32x4v*)(sc + c) + 1.0f);
            u32x2 o; o.x = pk2(y.x, y.y); o.y = pk2(y.z, y.w);
            *(u32x2*)(A2 + (size_t)row * DM + c) = o; }
        ss = wave_sum(ss);
        if (F.lane == 0) ssq[row] = rsqrtf(ss * (1.0f / DM) + EPS);
    }
}
__device__ __forceinline__ void norm_prep0_phase(Frame& F, const float* src_lat, const float* src_ctx, const float* g, const float* sc_base, bf16* A2, float* ssq) {
    const int gw = F.vcu * NWAVES + F.wave, NGW = F.G * NWAVES;
    for (int row = gw; row < MT; row += 2 * NGW) {
        const int rowb = row + NGW; const bool has1 = rowb < MT; const int row1 = has1 ? rowb : row;
        const float* x0 = row < MLAT ? src_lat + (size_t)row * DM : src_ctx + (size_t)(row - MLAT) * DM;
        const float* x1 = row1 < MLAT ? src_lat + (size_t)row1 * DM : src_ctx + (size_t)(row1 - MLAT) * DM;
        f32x4v v0[8], v1[8];
#pragma unroll
        for (int j = 0; j < 8; ++j) v0[j] = *(const f32x4v*)(x0 + 256 * j + 4 * F.lane);
#pragma unroll
        for (int j = 0; j < 8; ++j) v1[j] = *(const f32x4v*)(x1 + 256 * j + 4 * F.lane);
        const float* sc0 = sc_base + (size_t)(row < MLAT ? (row >> 13) : 4) * MODW; const float* sc1 = sc_base + (size_t)(row1 < MLAT ? (row1 >> 13) : 4) * MODW;
        float s0 = 0.f, s1 = 0.f;
#pragma unroll
        for (int j = 0; j < 8; ++j) { const int c = 256 * j + 4 * F.lane; const f32x4v gg = *(const f32x4v*)(g + c);
            s0 += (v0[j].x * v0[j].x + v0[j].y * v0[j].y) + (v0[j].z * v0[j].z + v0[j].w * v0[j].w);
            s1 += (v1[j].x * v1[j].x + v1[j].y * v1[j].y) + (v1[j].z * v1[j].z + v1[j].w * v1[j].w);
            const f32x4v y0 = v0[j] * gg * (*(const f32x4v*)(sc0 + c) + 1.0f), y1 = v1[j] * gg * (*(const f32x4v*)(sc1 + c) + 1.0f);
            u32x2 o0, o1; o0.x = pk2(y0.x, y0.y); o0.y = pk2(y0.z, y0.w); o1.x = pk2(y1.x, y1.y); o1.y = pk2(y1.z, y1.w);
            *(u32x2*)(A2 + (size_t)row * DM + c) = o0;
            if (has1) *(u32x2*)(A2 + (size_t)row1 * DM + c) = o1; }
        s0 = wave_sum(s0); s1 = wave_sum(s1);
        if (F.lane == 0) { ssq[row] = rsqrtf(s0 * (1.0f / DM) + EPS); if (has1) ssq[row1] = rsqrtf(s1 * (1.0f / DM) + EPS); }
    }
}
__device__ __forceinline__ void ctx_norm_phase(Frame& F, const float* src_ctx, const bf16* src_ctx_bf, const float* g, const float* sc_base, bf16* A2, float* ssq,
                                               const float* part, const float* gate_ctx, bf16* ctx_out, const float* ssqh) {
    LAS float* red = (LAS float*)(F.lds + RING_OFF);
    const float* sc = sc_base + (size_t)4 * MODW;
    const int hf = F.wave >> 2, cb = 1024 * hf + 4 * F.lane;
    __syncthreads();
    for (int rr = F.vcu * 4 + (F.wave & 3); rr < MCTX; rr += 4 * F.G) {
        const int row = MLAT + rr;
        f32x4v v[4];
        if (src_ctx) {
#pragma unroll
            for (int j = 0; j < 4; ++j) v[j] = *(const f32x4v*)(src_ctx + (size_t)rr * DM + cb + 256 * j); }
        else {
#pragma unroll
            for (int j = 0; j < 4; ++j) { const u32x2 r = *(const u32x2*)(src_ctx_bf + (size_t)rr * DM + cb + 256 * j); v[j] = (f32x4v){bf_lo(r.x), bf_hi(r.x), bf_lo(r.y), bf_hi(r.y)}; } }
        float na_scale = 1.0f;
        if (ssqh) { const float* sp = ssqh + (size_t)rr * NH; float t = 0.f;
#pragma unroll
            for (int hh = 0; hh < NH; ++hh) t += sp[hh];
            na_scale = rsqrtf(t * (1.0f / NAW) + EPS); }
        const float* pr = part + (size_t)rr * DM + cb;
        float ss = 0.f;
        f32x4v pa[2][NSPLIT];
#pragma unroll
        for (int j = 0; j < 4; ++j) {
            if ((j & 1) == 0) {
#pragma unroll
                for (int jj = 0; jj < 2; ++jj)
#pragma unroll
                    for (int s = 0; s < NSPLIT; ++s) pa[jj][s] = *(const f32x4v*)(pr + (size_t)s * MCTX * DM + 256 * (j + jj));
                asm volatile("" ::: "memory"); }
            f32x4v a = pa[j & 1][0];
#pragma unroll
            for (int s = 1; s < NSPLIT / 2; ++s) a += pa[j & 1][s];
            a = a * na_scale;
#pragma unroll
            for (int s = NSPLIT / 2; s < NSPLIT; ++s) a += pa[j & 1][s];
            const int c = cb + 256 * j;
            v[j] += *(const f32x4v*)(gate_ctx + c) * a;
            { u32x2 o; o.x = pk2(v[j].x, v[j].y); o.y = pk2(v[j].z, v[j].w); *(u32x2*)(ctx_out + (size_t)rr * DM + c) = o; }
            ss += (v[j].x * v[j].x + v[j].y * v[j].y) + (v[j].z * v[j].z + v[j].w * v[j].w);
            const f32x4v y = v[j] * (*(const f32x4v*)(g + c)) * (*(const f32x4v*)(sc + c) + 1.0f);
            u32x2 o; o.x = pk2(y.x, y.y); o.y = pk2(y.z, y.w);
            *(u32x2*)(A2 + (size_t)row * DM + c) = o; }
        ss = wave_sum(ss);
        if (F.lane == 0) red[F.wave] = ss;
        __syncthreads();
        if (hf == 0 && F.lane == 0) ssq[row] = rsqrtf((red[F.wave] + red[F.wave + 4]) * (1.0f / DM) + EPS);
        __syncthreads();
    }
}
__device__ __forceinline__ void ssq_reduce_phase(Frame& F, const float* ssqp, float* ssq, int nrows) {
    const int gt = F.vcu * (NWAVES * 64) + F.tid, NGT = F.G * NWAVES * 64;
    for (int it = gt; it < 4 * nrows; it += NGT) { const int row = it >> 2, q = it & 3; float s = 0.f;
#pragma unroll
        for (int k = 0; k < 8; ++k) s += ssqp[(size_t)(8 * q + k) * MT + row];
        s += dpp_mov<0xB1>(s); s += dpp_mov<0x4E>(s);
        if (q == 0) ssq[row] = rsqrtf(s * (1.0f / DM) + EPS); }
}
__device__ __forceinline__ void shw_phase(Frame& F, const bf16* WT, const float* sh_base, float* shw, int N, int cu_rank, int n_cus) {
    LAS float* SH = (LAS float*)(F.lds + RING_OFF);
    __syncthreads();
    for (int i = F.tid; i < 5 * DM; i += NWAVES * 64) SH[i] = sh_base[(size_t)(i / DM) * MODW + (i % DM)];
    __syncthreads();
    const int gw = cu_rank * NWAVES + F.wave, NGW = n_cus * NWAVES;
    for (int n = gw; n < N; n += NGW) {
        float w[4][8];
#pragma unroll
        for (int j = 0; j < 4; ++j) { const v4u wv = *(const GAS v4u*)(WT + (size_t)n * DM + 512 * j + 8 * F.lane);
            w[j][0] = bf_lo(wv.x); w[j][1] = bf_hi(wv.x); w[j][2] = bf_lo(wv.y); w[j][3] = bf_hi(wv.y); w[j][4] = bf_lo(wv.z); w[j][5] = bf_hi(wv.z); w[j][6] = bf_lo(wv.w); w[j][7] = bf_hi(wv.w); }
        float d[5];
#pragma unroll
        for (int r = 0; r < 5; ++r) { d[r] = 0.f;
#pragma unroll
            for (int j = 0; j < 4; ++j) { const f32x4v s0 = *(const LAS f32x4v*)(SH + r * DM + 512 * j + 8 * F.lane), s1 = *(const LAS f32x4v*)(SH + r * DM + 512 * j + 8 * F.lane + 4);
                d[r] += (w[j][0] * s0.x + w[j][1] * s0.y) + (w[j][2] * s0.z + w[j][3] * s0.w) + (w[j][4] * s1.x + w[j][5] * s1.y) + (w[j][6] * s1.z + w[j][7] * s1.w); } }
#pragma unroll
        for (int r = 0; r < 5; ++r) d[r] = wave_sum(d[r]);
        if (F.lane == 0) {
#pragma unroll
            for (int r = 0; r < 5; ++r) shw[(size_t)r * N + n] = d[r]; }
    }
}
__device__ __forceinline__ void final_norm_phase(Frame& F, const bf16* X, const float* g, float* out) {
    const int gw = F.vcu * NWAVES + F.wave, NGW = F.G * NWAVES;
    f32x4v gg[8];
#pragma unroll
    for (int j = 0; j < 8; ++j) gg[j] = *(const f32x4v*)(g + 256 * j + 4 * F.lane);
    for (int row = gw; row < MLAT; row += 2 * NGW) {
        const int row1 = row + NGW; const bool has1 = row1 < MLAT;
        const bf16* xr0 = X + (size_t)row * DM; const bf16* xr1 = X + (size_t)(has1 ? row1 : row) * DM;
        u32x2 r0[8], r1[8];
#pragma unroll
        for (int j = 0; j < 8; ++j) r0[j] = *(const u32x2*)(xr0 + 256 * j + 4 * F.lane);
#pragma unroll
        for (int j = 0; j < 8; ++j) r1[j] = *(const u32x2*)(xr1 + 256 * j + 4 * F.lane);
        f32x4v v0[8], v1[8]; float s0 = 0.f, s1 = 0.f;
#pragma unroll
        for (int j = 0; j < 8; ++j) { v0[j] = (f32x4v){bf_lo(r0[j].x), bf_hi(r0[j].x), bf_lo(r0[j].y), bf_hi(r0[j].y)};
            s0 += (v0[j].x * v0[j].x + v0[j].y * v0[j].y) + (v0[j].z * v0[j].z + v0[j].w * v0[j].w); }
#pragma unroll
        for (int j = 0; j < 8; ++j) { v1[j] = (f32x4v){bf_lo(r1[j].x), bf_hi(r1[j].x), bf_lo(r1[j].y), bf_hi(r1[j].y)};
            s1 += (v1[j].x * v1[j].x + v1[j].y * v1[j].y) + (v1[j].z * v1[j].z + v1[j].w * v1[j].w); }
        const float rstd0 = rsqrtf(wave_sum(s0) * (1.0f / DM) + EPS), rstd1 = rsqrtf(wave_sum(s1) * (1.0f / DM) + EPS);
#pragma unroll
        for (int j = 0; j < 8; ++j) *(f32x4v*)(out + (size_t)row * DM + 256 * j + 4 * F.lane) = (v0[j] * rstd0) * gg[j];
        if (has1) {
#pragma unroll
            for (int j = 0; j < 8; ++j) *(f32x4v*)(out + (size_t)row1 * DM + 256 * j + 4 * F.lane) = (v1[j] * rstd1) * gg[j]; }
    }
}

namespace mix {
constexpr int KSTR = 272, VSTR = 288;
constexpr int KBUF = 64 * KSTR, VBUF = 64 * VSTR, CHB = KBUF + VBUF;
constexpr int BIAS_OFF = 2 * CHB;
constexpr int CW_OFF = BIAS_OFF + NH * RPB_HS * 4, GCV_OFF = CW_OFF + 3 * CVW * 4;
constexpr int MIX_LDS = GCV_OFF + CVW * 4;
static_assert(CW_OFF % 16 == 0, "LDS alignment");
typedef float f32x2_t __attribute__((ext_vector_type(2))); typedef __bf16 bf16x2_t __attribute__((ext_vector_type(2)));
__device__ __forceinline__ unsigned cvtpk(float lo, float hi) { f32x2_t v = {lo, hi}; bf16x2_t b = __builtin_convertvector(v, bf16x2_t); return __builtin_bit_cast(unsigned, b); }
static_assert(MIX_LDS <= RING_BYTES, "mixer LDS");
constexpr float LOG2E = 1.4426950408889634f;
constexpr float SC2 = 0.08838834764831845f * LOG2E;
constexpr float NEG = -1.0e30f;

struct ChunkRegs { v4u k0, k1, v0, v1; };
__device__ __forceinline__ void chunk_load(ChunkRegs& R, const bf16* P, int tid, int h, int ci, int nloc, int a_lo, int lat0, int ctx0) {
    const int krow0 = ci < nloc ? lat0 + (a_lo + ci) * GRID_W : ctx0 + (ci - nloc) * 64;
    const int key = tid >> 4, c16 = tid & 15;
    const bf16* p0 = P + (size_t)(krow0 + key) * PPITCH + h * HD + 8 * c16;
    const bf16* p1 = p0 + (size_t)32 * PPITCH;
    R.k0 = *(const GAS v4u*)(p0 + COL_K); R.k1 = *(const GAS v4u*)(p1 + COL_K);
    R.v0 = *(const GAS v4u*)(p0 + COL_V); R.v1 = *(const GAS v4u*)(p1 + COL_V);
}
__device__ __forceinline__ void chunk_store(const ChunkRegs& R, LAS unsigned char* buf, int tid) {
    const int key = tid >> 4, c16 = tid & 15;
    *(LAS v4u*)(buf + key * KSTR + 16 * c16) = R.k0; *(LAS v4u*)(buf + (key + 32) * KSTR + 16 * c16) = R.k1;
    *(LAS v4u*)(buf + KBUF + key * VSTR + 16 * c16) = R.v0; *(LAS v4u*)(buf + KBUF + (key + 32) * VSTR + 16 * c16) = R.v1;
}

template <unsigned NEED, bool LOC, class LD>
__device__ __forceinline__ void chunk_compute(const LAS unsigned char* Kb, const LAS unsigned char* Vb, bf16x8 (&qf)[4], f32x4v (&O)[8], float& m_run, float& l_run,
                                              const LAS float* bt, int qi, int g, int d0, int v0, const bf16* qnext, const LD& issue_prefetch) {
    f32x4v sa[4];
#pragma unroll
    for (int kt = 0; kt < 4; ++kt) sa[kt] = (f32x4v){0.f, 0.f, 0.f, 0.f};
    const LAS unsigned char* kp = Kb + qi * KSTR + 16 * g;
    bf16x8 kfr[2][4];
#define MIX_KREAD(set, ks_) do { _Pragma("unroll") for (int kt = 0; kt < 4; ++kt) if ((NEED >> kt) & 1u) kfr[set][kt] = *(const LAS bf16x8*)(kp + 16 * kt * KSTR + 64 * (ks_)); } while (0)
    MIX_KREAD(0, 0);
#pragma unroll
    for (int ks = 0; ks < 4; ++ks) {
        if (ks + 1 < 4) { if (((ks + 1) & 1) == 0) MIX_KREAD(0, ks + 1); else MIX_KREAD(1, ks + 1); }
        __builtin_amdgcn_sched_barrier(0);
#pragma unroll
        for (int kt = 0; kt < 4; ++kt)
            if ((NEED >> kt) & 1u) sa[kt] = __builtin_amdgcn_mfma_f32_16x16x32_bf16(kfr[ks & 1][kt], qf[ks], sa[kt], 0, 0, 0);
        __builtin_amdgcn_sched_barrier(0);
    }
#undef MIX_KREAD
    constexpr bool NP0 = (NEED & 3u) != 0u, NP1 = (NEED & 0xCu) != 0u; constexpr int NG = 2 * ((NP0 ? 1 : 0) + (NP1 ? 1 : 0));
#define MIX_PPOF(gi) (NP0 ? ((gi) >> 1) : 1)
    const LAS unsigned char* vbase = Vb + (4 * g + (qi >> 2)) * VSTR + 8 * (qi & 3);
    v4i16_t va[2][8];
#define MIX_VREAD(set, gi) do { _Pragma("unroll") for (int d4 = 0; d4 < 4; ++d4) { const int dt_ = 4 * ((gi) & 1) + d4; \
        va[set][d4] = __builtin_amdgcn_ds_read_tr16_b64_v4i16((LAS v4i16_t*)(vbase + 32 * MIX_PPOF(gi) * VSTR + 32 * dt_)); \
        va[set][4 + d4] = __builtin_amdgcn_ds_read_tr16_b64_v4i16((LAS v4i16_t*)(vbase + (32 * MIX_PPOF(gi) + 16) * VSTR + 32 * dt_)); } } while (0)
    MIX_VREAD(0, 0);
    issue_prefetch();
    if (!LOC) {
#pragma unroll
        for (int ks = 0; ks < 4; ++ks) qf[ks] = *(const GAS bf16x8*)(qnext + 32 * ks); }
    float s[4][4];
    if (LOC) {
        float bv[4][4];
#pragma unroll
        for (int kt = 0; kt < 4; ++kt)
            if ((NEED >> kt) & 1u) {
#pragma unroll
                for (int e = 0; e < 4; ++e) { const int dcol = d0 + 16 * kt + e; bv[kt][e] = bt[min(max(dcol, 0), RPB_C - 1)]; asm volatile("" : "+v"(bv[kt][e])); } }
#pragma unroll
        for (int kt = 0; kt < 4; ++kt)
#pragma unroll
            for (int e = 0; e < 4; ++e) {
                if ((NEED >> kt) & 1u) { const bool valid = (unsigned)(v0 + 16 * kt + e) < (unsigned)WIN_C; s[kt][e] = valid ? sa[kt][e] * SC2 + bv[kt][e] : NEG; }
                else s[kt][e] = NEG; }
    } else {
#pragma unroll
        for (int kt = 0; kt < 4; ++kt)
#pragma unroll
            for (int e = 0; e < 4; ++e) s[kt][e] = ((NEED >> kt) & 1u) ? sa[kt][e] * SC2 : NEG;
    }
    float mx = NEG;
#pragma unroll
    for (int kt = 0; kt < 4; ++kt)
        if ((NEED >> kt) & 1u) {
#pragma unroll
            for (int e = 0; e < 4; ++e) mx = fmaxf(mx, s[kt][e]); }
    mx = x32_max(x16_max(mx));
    const float m_new = fmaxf(m_run, mx);
    {
        const float alpha = __builtin_amdgcn_exp2f(m_run - m_new);
        l_run *= alpha;
#pragma unroll
        for (int dt = 0; dt < 8; ++dt) O[dt] = O[dt] * alpha;
    }
    m_run = m_new;
    float psum = 0.f; unsigned pk[4][2];
#pragma unroll
    for (int kt = 0; kt < 4; ++kt) {
        if ((NEED >> kt) & 1u) { float p[4];
#pragma unroll
            for (int e = 0; e < 4; ++e) { p[e] = __builtin_amdgcn_exp2f(s[kt][e] - m_new); psum += p[e]; }
            pk[kt][0] = cvtpk(p[0], p[1]); pk[kt][1] = cvtpk(p[2], p[3]); }
        else { pk[kt][0] = 0u; pk[kt][1] = 0u; } }
    l_run += psum;
    bf16x8 pf[2];
#pragma unroll
    for (int pp = 0; pp < 2; ++pp) { const v4u pw = (v4u){pk[2 * pp][0], pk[2 * pp][1], pk[2 * pp + 1][0], pk[2 * pp + 1][1]}; pf[pp] = __builtin_bit_cast(bf16x8, pw); }
#pragma unroll
    for (int gi = 0; gi < NG; ++gi) {
        if (gi + 1 < NG) { if (((gi + 1) & 1) == 0) MIX_VREAD(0, gi + 1); else MIX_VREAD(1, gi + 1); }
#pragma unroll
        for (int d4 = 0; d4 < 4; ++d4) { const int dt = 4 * (gi & 1) + d4; const v4i16_t lo = va[gi & 1][d4], hi = va[gi & 1][4 + d4];
            const bf16x8 vf = (bf16x8){lo[0], lo[1], lo[2], lo[3], hi[0], hi[1], hi[2], hi[3]};
            O[dt] = __builtin_amdgcn_mfma_f32_16x16x32_bf16(vf, pf[MIX_PPOF(gi)], O[dt], 0, 0, 0); }
    }
#undef MIX_VREAD
#undef MIX_PPOF
}

__device__ __forceinline__ void mixer_unit(Frame& F, int u, const bf16* P, bf16* MIXO, const float* conv_w, const float* g_na, const float* g_cv, float* ssqh, bool bal, float* rna) {
    LAS unsigned char* L = F.lds + RING_OFF;
    const LAS float* btab = (const LAS float*)(L + BIAS_OFF);
    const int w = F.wave;
    const bool lat = u < 256;
    int b, tok0, nloc, a_lo, r0, seq_lo, seq_hi;
    if (lat) { b = u >> 6; r0 = 2 * (u & 63); tok0 = b * SEQ + r0 * GRID_W; a_lo = min(max(r0 - 4, 0), GRID_R - WIN_R); const int a_hi = min(max(r0 + 1 - 4, 0), GRID_R - WIN_R) + WIN_R - 1; nloc = a_hi - a_lo + 1;
               seq_lo = b * SEQ; seq_hi = seq_lo + SEQ; }
    else { const int v = u - 256; b = v >> 4; r0 = 0; tok0 = MLAT + b * CTXL + 128 * ((v >> 3) & 1); a_lo = 0; nloc = 0; seq_lo = MLAT + b * CTXL; seq_hi = seq_lo + CTXL; }
    const int h_lo = lat ? 0 : ((u - 256) & 7), h_hi = lat ? NH : h_lo + 1;
    const int lat0 = b * SEQ, ctx0 = MLAT + b * CTXL;
    const int nch = nloc + 4;
    const int rw = r0 + (w >> 2), qt = (w & 3) ^ (w >> 2);
    const int tw = 64 * (w >> 2) + 16 * qt;
    const int rs_w = min(max(rw - 4, 0), GRID_R - WIN_R);
    const int kb0 = qt == 0 ? 0 : qt == 1 ? 8 : qt == 2 ? 24 : 32;

    const bool conv_first = false;
#pragma unroll 1
    for (int pass = 0; pass < 2; ++pass) {
    if ((pass == 0) != conv_first) {
    int tid_a = threadIdx.x; asm volatile("" : "+v"(tid_a));
    const int tid = tid_a, lane_a = tid_a & 63, qi = lane_a & 15, g = lane_a >> 4;
    const int cq = 16 * qt + qi;
    const int cs = min(max(cq - 8, 0), GRID_W - WIN_C);
    const int d0 = 4 * g - cq + (WIN_C - 1), v0 = 4 * g - cs;
    const int qrow = tok0 + tw + qi;
    ChunkRegs CR;
    bf16x8 qf[4];
#pragma unroll
    for (int ks = 0; ks < 4; ++ks) qf[ks] = *(const GAS bf16x8*)(P + (size_t)qrow * PPITCH + COL_Q + h_lo * HD + 32 * ks + 8 * g);
    const int total = (h_hi - h_lo) * nch;
    chunk_load(CR, P, tid, h_lo, 0, nloc, a_lo, lat0, ctx0);
    chunk_store(CR, L, tid);
    __syncthreads();

    float ssq = 0.f;
    f32x4v O[8]; float m_run = NEG, l_run = 0.f;
#pragma unroll
    for (int dt = 0; dt < 8; ++dt) O[dt] = (f32x4v){0.f, 0.f, 0.f, 0.f};
    int h = h_lo, ci = 0;
    int h2 = h_lo, c2 = 1;
#define MIX_STEP(BUF, S_) do { \
        const bool lastc = ci == nch - 1; \
        auto pre = [&]() { chunk_load(CR, P, tid, min(h2, h_hi - 1), c2, nloc, a_lo, lat0, ctx0); };     \
        const LAS unsigned char* Kb = L + (BUF) * CHB; const LAS unsigned char* Vb = Kb + KBUF; \
        if (ci < nloc) { const int a = a_lo + ci; \
            if (a >= rs_w && a < rs_w + WIN_R) { const LAS float* bt = btab + h * RPB_HS + (a - rw + WIN_R - 1) * RPB_C; \
                chunk_compute<0x3u, true>(Kb + kb0 * KSTR, Vb + kb0 * VSTR, qf, O, m_run, l_run, bt, qi, g, d0 + kb0, v0 + kb0, (const bf16*)nullptr, pre); }     \
            else pre(); \
        } else chunk_compute<0xFu, false>(Kb, Vb, qf, O, m_run, l_run, btab, qi, g, d0, v0, P + (size_t)qrow * PPITCH + COL_Q + ((lastc && h < h_hi - 1) ? h + 1 : h) * HD + 8 * g, pre); \
        chunk_store(CR, L + (1 - (BUF)) * CHB, tid);     \
        if (lastc) { float lt = x32_sum(x16_sum(l_run)); const float inv = 1.0f / lt; \
            bf16* op = MIXO + (size_t)qrow * DM + h * HD + 4 * g; \
            _Pragma("unroll") for (int dt = 0; dt < 8; ++dt) { f32x4v o = O[dt] * inv; ssq += (o.x * o.x + o.y * o.y) + (o.z * o.z + o.w * o.w); \
                u32x2 ov; ov.x = cvtpk(o.x, o.y); ov.y = cvtpk(o.z, o.w); *(GAS u32x2*)(op + 16 * dt) = ov; O[dt] = (f32x4v){0.f, 0.f, 0.f, 0.f}; } \
            m_run = NEG; l_run = 0.f; } \
        LDS_WAIT(); __builtin_amdgcn_s_barrier(); asm volatile("" ::: "memory"); __builtin_amdgcn_s_barrier(); asm volatile("" ::: "memory"); __builtin_amdgcn_s_barrier(); asm volatile("" ::: "memory");     \
        if (++ci == nch) { ci = 0; ++h; } if (++c2 == nch) { c2 = 0; ++h2; } \
    } while (0)
    for (int s = 0; s < total; s += 2) { MIX_STEP(0, s); MIX_STEP(1, s + 1); }
#undef MIX_STEP
    ssq = x32_sum(x16_sum(ssq));
    const float rstd = rsqrtf(ssq * (1.0f / NAW) + EPS);
    if (!lat && g == 0) ssqh[(size_t)(qrow - MLAT) * NH + h_lo] = ssq;
    if (lat && (lane_a >> 4) == 0) rna[tok0 + tw + qi] = rstd;
    } else {
    {
        int lane_c = F.lane; asm volatile("" : "+v"(lane_c)); const int lane = lane_c;
        const LAS float* cwl = (const LAS float*)(L + CW_OFF) + 8 * lane; const LAS float* gcl = (const LAS float*)(L + GCV_OFF) + 8 * lane;
        struct CvSet { v4u c[2], b[2]; };
        float cu[3][2][8];
#define CV_PROD(dst, A_) do { _Pragma("unroll") for (int j = 0; j < 2; ++j) { const v4u a_ = (A_)[j]; \
            dst[j][0] = bf_lo(a_.x); dst[j][1] = bf_hi(a_.x); dst[j][2] = bf_lo(a_.y); dst[j][3] = bf_hi(a_.y); \
            dst[j][4] = bf_lo(a_.z); dst[j][5] = bf_hi(a_.z); dst[j][6] = bf_lo(a_.w); dst[j][7] = bf_hi(a_.w); } } while (0)
#define CV_LOADROW(CC, row) do { const bool ok_ = (row) >= seq_lo && (row) < seq_hi; _Pragma("unroll") for (int j = 0; j < 2; ++j) { (CC)[j] = (v4u){0u, 0u, 0u, 0u}; \
            if (ok_) (CC)[j] = *(const GAS v4u*)(P + (size_t)(row) * PPITCH + COL_CG + 8 * lane + 512 * j); } } while (0)
#define CV_ISSUE(S, tt) do { CV_LOADROW((S).c, (tt) + 1); _Pragma("unroll") for (int j = 0; j < 2; ++j) (S).b[j] = *(const GAS v4u*)(P + (size_t)(tt) * PPITCH + COL_BG + 8 * lane + 512 * j); } while (0)
#define CV_TOKEN(S, tt, more) do { \
            CV_PROD(cu[2], (S).c); const v4u bg0_ = (S).b[0], bg1_ = (S).b[1]; \
            if (more) CV_ISSUE(S, (tt) + 1); \
            float o[2][8]; float ss = 0.f; \
            _Pragma("unroll") for (int j = 0; j < 2; ++j) { const v4u bgv = j ? bg1_ : bg0_; \
                const float bgf[8] = {bf_lo(bgv.x), bf_hi(bgv.x), bf_lo(bgv.y), bf_hi(bgv.y), bf_lo(bgv.z), bf_hi(bgv.z), bf_lo(bgv.w), bf_hi(bgv.w)}; \
                _Pragma("unroll") for (int e4 = 0; e4 < 2; ++e4) { const f32x4v w0 = *(const LAS f32x4v*)(cwl + 512 * j + 4 * e4), w1 = *(const LAS f32x4v*)(cwl + CVW + 512 * j + 4 * e4), w2 = *(const LAS f32x4v*)(cwl + 2 * CVW + 512 * j + 4 * e4); \
                    _Pragma("unroll") for (int e = 0; e < 4; ++e) { const int ee = 4 * e4 + e; const float cvv = w0[e] * cu[0][j][ee] + w1[e] * cu[1][j][ee] + w2[e] * cu[2][j][ee]; o[j][ee] = bgf[ee] * cvv; ss += o[j][ee] * o[j][ee]; } } } \
            const float rs = rsqrtf(wave_sum(ss) * (1.0f / CVW) + EPS); \
            _Pragma("unroll") for (int j = 0; j < 2; ++j) { const f32x4v g0 = *(const LAS f32x4v*)(gcl + 512 * j), g1 = *(const LAS f32x4v*)(gcl + 512 * j + 4); v4u ov; \
                ov.x = cvtpk(o[j][0] * rs * g0.x, o[j][1] * rs * g0.y); ov.y = cvtpk(o[j][2] * rs * g0.z, o[j][3] * rs * g0.w); \
                ov.z = cvtpk(o[j][4] * rs * g1.x, o[j][5] * rs * g1.y); ov.w = cvtpk(o[j][6] * rs * g1.z, o[j][7] * rs * g1.w); \
                *(GAS v4u*)(MIXO + (size_t)(tt) * DM + NAW + 8 * lane + 512 * j) = ov; } \
            _Pragma("unroll") for (int j = 0; j < 2; ++j) _Pragma("unroll") for (int e = 0; e < 8; ++e) { cu[0][j][e] = cu[1][j][e]; cu[1][j][e] = cu[2][j][e]; } \
        } while (0)
        CvSet SA;
        const int gm = u & 3;
        const int nseg = (lat && bal && gm != 3) ? 2 : 1;
#pragma unroll 1
        for (int seg = 0; seg < nseg; ++seg) {
        const int ntok = !lat ? 2 : (seg == 1 ? 2 : ((bal && gm == 3) ? 10 : 16));
        const int tc0 = !lat ? tok0 + 16 * h_lo + 2 * w : (seg == 1 ? tok0 + (3 - gm) * 128 + 80 + 16 * gm + 2 * w : ((bal && gm == 3) ? tok0 + 10 * w : tok0 + 16 * w));
        { v4u c_[2]; CV_LOADROW(c_, tc0 - 1); CV_PROD(cu[0], c_); CV_LOADROW(c_, tc0); CV_PROD(cu[1], c_); }
        CV_ISSUE(SA, tc0);
#pragma unroll 1
        for (int t = 0; t < ntok; ++t) CV_TOKEN(SA, tc0 + t, t + 1 < ntok);
        }
#undef CV_PROD
#undef CV_LOADROW
#undef CV_ISSUE
#undef CV_TOKEN
    }
    }
    }
}
__device__ __forceinline__ void mixer_phase(Frame& F, const bf16* P, bf16* MIXO, const float* rpb_l, const float* conv_w, const float* g_na, const float* g_cv, int n_units, float* ssqh, float* rna) {
    LAS float* btab = (LAS float*)(F.lds + RING_OFF + BIAS_OFF);
    for (int i = F.tid; i < NH * RPB_HS; i += NWAVES * 64) btab[i] = rpb_l[i] * LOG2E;
    { LAS float* cwl = (LAS float*)(F.lds + RING_OFF + CW_OFF); for (int i = F.tid; i < 3 * CVW; i += NWAVES * 64) cwl[i] = conv_w[i];
      LAS float* gcl = (LAS float*)(F.lds + RING_OFF + GCV_OFF); for (int i = F.tid; i < CVW; i += NWAVES * 64) gcl[i] = g_cv[i]; }
    __syncthreads();
    const bool bal = n_units > 256 && F.G == 256;
    for (int u = F.vcu; u < n_units && u < 256; u += F.G) mixer_unit(F, u, P, MIXO, conv_w, g_na, g_cv, ssqh, bal, rna);
    if (n_units > 256 && F.G == 256) { if ((F.vcu & 3) == 3) mixer_unit(F, 256 + (F.vcu >> 2), P, MIXO, conv_w, g_na, g_cv, ssqh, false, rna); }
    else for (int u = 256 + F.vcu; u < n_units; u += F.G) mixer_unit(F, u, P, MIXO, conv_w, g_na, g_cv, ssqh, false, rna);
    __syncthreads();
}
}

struct Args { const float* in[17]; float* out; unsigned char* ws; int ph_lo, ph_hi; };
__global__ void __launch_bounds__(NWAVES * 64, 2) skel_fwd(Args args) {
    extern __shared__ __attribute__((aligned(16))) unsigned char lds[];
    Frame F;
    F.lds = (LAS unsigned char*)lds;
    F.MISC = (volatile LAS unsigned*)(F.lds + MISC_OFF);
    F.tid = threadIdx.x; F.lane = F.tid & 63; F.wave = __builtin_amdgcn_readfirstlane(F.tid >> 6);
    F.G = gridDim.x; { const int bx = blockIdx.x; F.vcu = (F.G % 8 == 0) ? (bx % 8) * (F.G / 8) + bx / 8 : bx; }
    unsigned char* ws = args.ws;
    F.ctl = (gu32*)(ws + WS_CTL);
    const float *in_x = args.in[0], *in_ctx = args.in[2];
#define MOD ((float*)(ws + WS_MOD))
#define VEC ((const float*)(ws + WS_VEC))
#define WIN_T ((bf16*)(ws + WS_WIN))
#define WOUT_T ((bf16*)(ws + WS_WOUT))
#define W1_T ((bf16*)(ws + WS_W1))
#define W2_T ((bf16*)(ws + WS_W2))
#define X ((bf16*)(ws + WS_X))
#define XN ((bf16*)(ws + WS_XN))
#define PB ((bf16*)(ws + WS_P))
#define MIXB ((bf16*)(ws + WS_MIX))
#define HB ((bf16*)(ws + WS_H))
#define PO ((float*)(ws + WS_PO))
#define PM ((float*)(ws + WS_PM))
#define SSQ ((float*)(ws + WS_SSQ))
#define SHW ((float*)(ws + WS_SHW))
#define SSQP ((float*)(ws + WS_SSQP))
    for (int u = F.tid; u < (LDS_BYTES - LDSCTL_OFF) / 4; u += NWAVES * 64) ((LAS unsigned*)(F.lds + LDSCTL_OFF))[u] = 0u;
    __syncthreads();
#if MK_PER_PHASE
#define GRID_BAR() do { } while (0)
#else
    XcdBarrier bar = xcd_barrier_post((unsigned*)(F.ctl + CW_BAR), F.MISC + 8);
#define GRID_BAR() xcd_barrier(bar)
#endif
    const int lo = args.ph_lo, hi = args.ph_hi;
#define IN(k) (lo <= (k) && (k) < hi)
#define SEAM(k) do { if (IN((k) + 1)) GRID_BAR(); } while (0)

    if (IN(0)) {
        ProIn I{args.in[1], args.in[3], args.in[4], args.in[5], args.in[7], args.in[12], args.in[14], args.in[15], args.in[6], args.in[13], args.in[8], args.in[9], args.in[10], args.in[11], args.in[16], MOD, (float*)(ws + WS_VEC), WIN_T, WOUT_T, W1_T, W2_T};
        p0_prologue(F, I);
        SEAM(0);
    }
    for (int l = 0; l < DEPTH; ++l) {
        const int pb = 1 + 7 * l;
        const bool last = l == DEPTH - 1;
        const int Mg = last ? MLAT : MT;
        const float* mod_l = MOD + (size_t)l * 5 * MODW;
        const float* vec_l = VEC + (size_t)l * VEC_L;
        bf16* const Xc = X + (size_t)MLAT * DM;
        float* ssq1 = SSQ + (size_t)(2 * l) * MT; float* ssq2 = SSQ + (size_t)(2 * l + 1) * MT;
        float* shw1 = SHW + (size_t)l * 5 * INC; float* shw2 = SHW + (size_t)DEPTH * 5 * INC + (size_t)l * 5 * DFF;
#define OPAQUE_TID() do { int t_ = threadIdx.x; asm volatile("" : "+v"(t_)); F.tid = t_; F.lane = t_ & 63; F.wave = __builtin_amdgcn_readfirstlane(t_ >> 6); } while (0)
        if (IN(pb + 0)) { OPAQUE_TID();
            if (l == 0) norm_prep0_phase(F, in_x, in_ctx, vec_l + VEC_G1, mod_l + 1 * DM, XN, ssq1);
            else { ctx_norm_phase(F, (const float*)nullptr, Xc, vec_l + VEC_G1, mod_l + 1 * DM, XN, ssq1, PM, mod_l - 5 * MODW + 4 * MODW + 5 * DM, Xc, (const float*)nullptr);
                   ssq_reduce_phase(F, SSQP, ssq1, MLAT); }
            if (l == 0) { shw_phase(F, WIN_T, MOD + 0 * DM, SHW, INC, F.vcu, F.G);
                          shw_phase(F, W1_T, MOD + 3 * DM, SHW + (size_t)DEPTH * 5 * INC, DFF, F.vcu, F.G); }
            SEAM(pb + 0); }
        if (IN(pb + 1)) { OPAQUE_TID();
            pg8::Gemm g{XN, WIN_T + (size_t)l * INC * DM, MT, INC, DM}; pg8::CtxColsOrder S;
            S.init(MLAT, INC, F.G, (int)blockIdx.x, DM, MLAT / 256, last ? COL_K / 256 : 0, last ? (COL_BG - COL_K) / 256 : INC / 256);
            pg8::EpiBf16<0, true> E{PB, PPITCH, ssq1, shw1, INC, COL_CG / 256, COL_CG};
            pg8::gemm_phase<pg8::EpiBf16<0, true>, pg8::CtxColsOrder, true, true>(F.lds + RING_OFF, g, S, E, F.tid);
            if (!last) {
                const int nwg_ = (MT / 256) * (INC / 256), rounds_ = (nwg_ + F.G - 1) / F.G, first_idle = nwg_ - (rounds_ - 1) * F.G, c_ = (int)blockIdx.x;
                const bool all_ = first_idle >= F.G;
                if (all_ || c_ >= first_idle) { OPAQUE_TID();
                    const int rank_ = all_ ? F.vcu : c_ - first_idle, ncu_ = all_ ? F.G : F.G - first_idle;
                    shw_phase(F, WIN_T + (size_t)(l + 1) * INC * DM, MOD + (size_t)(l + 1) * 5 * MODW + 0 * DM, SHW + (size_t)(l + 1) * 5 * INC, INC, rank_, ncu_);
                    shw_phase(F, W1_T + (size_t)(l + 1) * DFF * DM, MOD + (size_t)(l + 1) * 5 * MODW + 3 * DM, SHW + (size_t)DEPTH * 5 * INC + (size_t)(l + 1) * 5 * DFF, DFF, rank_, ncu_); } }
            SEAM(pb + 1);
        }
        if (IN(pb + 2)) { OPAQUE_TID();
            mix::mixer_phase(F, PB, MIXB, vec_l + VEC_RPB, vec_l + VEC_CW, vec_l + VEC_GNA, vec_l + VEC_GCV, last ? 256 : 320, (float*)(ws + WS_VEC + 512 * 1024), (float*)(ws + WS_SSQ + 1536 * 1024));
            SEAM(pb + 2);
        }
        if (IN(pb + 3)) { OPAQUE_TID();
            pg8::Gemm g{MIXB, WOUT_T + (size_t)l * DM * DM, Mg, DM, DM}; pg8::CtxSplitOrder S; S.init(MLAT, DM, F.G, (int)blockIdx.x, DM, last ? 0 : NSPLIT, MLAT / 256);
            pg8::EpiGateResSplitMid E{{{l == 0 ? in_x : (const float*)nullptr, X, X, mod_l + 2 * DM, DM, MODW, XN, SSQP, MT, vec_l + VEC_G2, mod_l + 4 * DM}, PO, MLAT / 256, DM}, (const float*)(ws + WS_SSQ + 1536 * 1024)};
            pg8::gemm_phase<pg8::EpiGateResSplitMid, pg8::CtxSplitOrder, true, true>(F.lds + RING_OFF, g, S, E, F.tid);
            SEAM(pb + 3);
        }
        if (IN(pb + 4)) { OPAQUE_TID();
            if (!last) ctx_norm_phase(F, l == 0 ? in_ctx : (const float*)nullptr, Xc, vec_l + VEC_G2, mod_l + 4 * DM, XN, ssq2, PO, mod_l + 4 * MODW + 2 * DM, Xc, (const float*)(ws + WS_VEC + 512 * 1024));
            ssq_reduce_phase(F, SSQP, ssq2, MLAT);
            SEAM(pb + 4); }
        if (IN(pb + 5)) { OPAQUE_TID();
            pg8::Gemm g{XN, W1_T + (size_t)l * DFF * DM, Mg, DFF, DM}; pg8::StaticOrder S; S.init(Mg, DFF, F.G, (int)blockIdx.x, DM);
            pg8::EpiBf16<2> E{HB, DFF, ssq2, shw2, DFF};
            pg8::gemm_phase<pg8::EpiBf16<2>, pg8::StaticOrder, true, true>(F.lds + RING_OFF, g, S, E, F.tid);
            SEAM(pb + 5);
        }
        if (IN(pb + 6)) { OPAQUE_TID();
            pg8::Gemm g{HB, W2_T + (size_t)l * DM * DFF, Mg, DM, DFF}; pg8::CtxSplitOrder S; S.init(MLAT, DM, F.G, (int)blockIdx.x, DFF, last ? 0 : NSPLIT, MLAT / 256);
            pg8::EpiGateResSplit E{{(const float*)nullptr, X, X, mod_l + 5 * DM, DM, MODW, last ? (bf16*)nullptr : XN, SSQP, MT, vec_l + VEC_L + VEC_G1, mod_l + 5 * MODW + 1 * DM}, PM, MLAT / 256, DM};
            pg8::gemm_phase<pg8::EpiGateResSplit, pg8::CtxSplitOrder, true, true>(F.lds + RING_OFF, g, S, E, F.tid);
            SEAM(pb + 6);
        }
    }
    if (IN(N_PHASES - 1)) final_norm_phase(F, X, VEC + VEC_GF, args.out);
#undef IN
#undef SEAM
}

extern "C" void kernel_launch(void* const* d_in, const int* in_sizes, int n_in, void* d_out, int out_size, void* d_ws, size_t ws_size, hipStream_t stream) {
    static int grid = 0;
    if (grid == 0) {
        if (n_in != 17 || in_sizes[0] != MLAT * DM || out_size != MLAT * DM || ws_size < WS_END) { fprintf(stderr, "kernel_launch: shape/workspace mismatch: n_in %d, in0 %d, out %d, ws %zu (need %zu); nothing launched\n", n_in, n_in > 0 ? in_sizes[0] : -1, out_size, ws_size, (size_t)WS_END); grid = -1; return; }
        int dev = 0, cus = 0, per_cu = 0;
        if (hipGetDevice(&dev) != hipSuccess || hipDeviceGetAttribute(&cus, hipDeviceAttributeMultiprocessorCount, dev) != hipSuccess) { fprintf(stderr, "kernel_launch: hipGetDevice / hipDeviceGetAttribute failed; nothing launched\n"); grid = -1; return; }
        if (hipFuncSetAttribute((const void*)skel_fwd, hipFuncAttributeMaxDynamicSharedMemorySize, LDS_BYTES) != hipSuccess) { fprintf(stderr, "kernel_launch: hipFuncSetAttribute failed; nothing launched\n"); grid = -1; return; }
        if (hipOccupancyMaxActiveBlocksPerMultiprocessor(&per_cu, (const void*)skel_fwd, NWAVES * 64, LDS_BYTES) != hipSuccess || per_cu < 1)
            fprintf(stderr, "kernel_launch: note: the occupancy query reports %d workgroups per CU\n", per_cu);
        (void)hipGetLastError();
        grid = cus;
    }
    if (grid < 0) return;
    if (hipMemsetAsync((char*)d_ws + WS_CTL, 0, CTL_ZERO_BYTES, stream) != hipSuccess) { fprintf(stderr, "kernel_launch: hipMemsetAsync of the control words failed; nothing launched\n"); return; }
    Args a{};
    for (int i = 0; i < 17; ++i) a.in[i] = (const float*)d_in[i];
    a.out = (float*)d_out; a.ws = (unsigned char*)d_ws;
#if MK_PER_PHASE
    for (int p = 0; p < N_PHASES; ++p) { a.ph_lo = p; a.ph_hi = p + 1; hipLaunchKernelGGL(skel_fwd, dim3(grid), dim3(NWAVES * 64), LDS_BYTES, stream, a); }
#else
    a.ph_lo = 0; a.ph_hi = N_PHASES;
    hipLaunchKernelGGL(skel_fwd, dim3(grid), dim3(NWAVES * 64), LDS_BYTES, stream, a);
#endif
    const hipError_t le = hipPeekAtLastError();
    if (le != hipSuccess) fprintf(stderr, "kernel_launch: launch failed: %s (grid %d x %d threads, %d B LDS)\n", hipGetErrorName(le), grid, NWAVES * 64, LDS_BYTES);
}
```

```cpp
#include <hip/hip_runtime.h>
#include <cstdio>
#include <cstdint>
namespace pg8 {
#define PG8_LAS __attribute__((address_space(3)))
typedef unsigned short bf16_t;
typedef short bf16x8 __attribute__((ext_vector_type(8)));
typedef float f32x4 __attribute__((ext_vector_type(4)));
typedef unsigned u32x4 __attribute__((ext_vector_type(4)));
constexpr int BM = 256, BK = 64, HALF = 128, HTB = HALF * BK * 2  , STAGE_BYTES = 8 * HTB, NXCD = 8;

__host__ __device__ __forceinline__ int lds_byte(int r, int c) { const int st = (r >> 4) * 2 + (c >> 5), rr = r & 15, cc = c & 31, ob = rr * 64 + cc * 2; return st * 1024 + (ob ^ (((ob >> 9) & 1) << 5)); }
__host__ __device__ __forceinline__ void stage_rc(int b, int& R, int& C) { const int st = b / 1024, sb = b % 1024, swz = sb ^ (((sb >> 9) & 1) << 5); R = (st >> 1) * 16 + swz / 64; C = (st & 1) * 32 + (swz % 64) / 2; }
__host__ __device__ __forceinline__ int perm32(int rho) { const int n = rho >> 4, i = rho & 15; return 8 * (i >> 2) + 4 * n + (i & 3); }

struct Unit { int pm, pn, k0, nt, ks; };
struct Gemm { const bf16_t* A; const bf16_t* Bt; int M, N, K; };

struct StaticOrder {
    int nM, nN, nwg, G, c, ntk, WGM;
    __host__ __device__ void init(int M, int N, int G_, int c_, int K, int wgm = 4) { nM = M / BM; nN = N / BM; nwg = nM * nN; G = G_; c = c_; ntk = K / BK; WGM = wgm; }
    __host__ __device__ __forceinline__ void tile_of(int wgid, int& pm, int& pn) const {
        { const int q = nwg / NXCD, r = nwg % NXCD, xcd = wgid % NXCD, off = wgid / NXCD; wgid = (xcd < r ? xcd * (q + 1) : r * (q + 1) + (xcd - r) * q) + off; }
        const int nig = WGM * nN, gid = wgid / nig, fm = gid * WGM, gsz = (nM - fm) < WGM ? (nM - fm) : WGM;
        pm = fm + ((wgid % nig) % gsz); pn = (wgid % nig) / gsz; }
    __host__ __device__ __forceinline__ bool next(int i, Unit& u) const {
        const long L = (long)i * G + c; const bool ok = L < nwg;
        int pm = 0, pn = 0; tile_of(ok ? (int)L : 0, pm, pn);
        u.pm = pm; u.pn = pn; u.k0 = 0; u.nt = ntk; u.ks = -1; return ok;
    }
    __device__ __forceinline__ void a_ready(const Unit&) const {}
    __device__ __forceinline__ void done(const Unit&) const {}
};
struct CtxColsOrder {
    StaticOrder lat; int NL, NC, nc, c0, ctx_pm0;
    __host__ __device__ void init(int M_lat, int N, int G_, int c_, int K, int ctx_pm0_, int c0_, int nc_, int wgm = 4) { lat.init(M_lat, N, G_, c_, K, wgm); NL = lat.nwg; ctx_pm0 = ctx_pm0_; c0 = c0_; nc = nc_; NC = 4 * nc_; }
    __host__ __device__ __forceinline__ bool next(int i, Unit& u) const {
        const long L = (long)i * lat.G + lat.c; const bool isl = L < NL; const long jl = L - NL; const bool isc = !isl && jl < NC;
        int pm = 0, pn = 0; lat.tile_of(isl ? (int)L : 0, pm, pn);
        if (isc) { const int j = (int)jl; pn = c0 + j % nc; pm = ctx_pm0 + j / nc; }
        u.pm = pm; u.pn = pn; u.k0 = 0; u.nt = lat.ntk; u.ks = -1; return isl || isc;
    }
    __device__ __forceinline__ void a_ready(const Unit&) const {}
    __device__ __forceinline__ void done(const Unit&) const {}
};
struct CtxSplitOrder {
    StaticOrder lat; int NL, NC, nN, ctx_pm0, kslice;
    __host__ __device__ void init(int M_lat, int N, int G_, int c_, int K, int nsplit  , int ctx_pm0_, int wgm = 4) {
        lat.init(M_lat, N, G_, c_, K, wgm); NL = lat.nwg; nN = N / BM; ctx_pm0 = ctx_pm0_; NC = nsplit ? 4 * nN * nsplit : 0; kslice = nsplit ? K / nsplit : K; }
    __host__ __device__ __forceinline__ bool next(int i, Unit& u) const {
        const long L = (long)i * lat.G + lat.c; const bool isl = L < NL; const long jl = L - NL; const bool isc = !isl && jl < NC;
        int pm = 0, pn = 0; lat.tile_of(isl ? (int)L : 0, pm, pn);
        int k0 = 0, nt = lat.ntk, ks = -1;
        if (isc) { const int j = (int)jl, nsp = NC / (4 * nN); ks = j % nsp; const int r = j / nsp; pn = r % nN; pm = ctx_pm0 + r / nN; k0 = ks * kslice; nt = kslice / BK; }
        u.pm = pm; u.pn = pn; u.k0 = k0; u.nt = nt; u.ks = ks; return isl || isc;
    }
    __device__ __forceinline__ void a_ready(const Unit&) const {}
    __device__ __forceinline__ void done(const Unit&) const {}
};

__device__ __forceinline__ float xsum16(float v) { const unsigned x = __builtin_bit_cast(unsigned, v); const auto r = __builtin_amdgcn_permlane16_swap(x, x, false, false); return __builtin_bit_cast(float, (unsigned)r[0]) + __builtin_bit_cast(float, (unsigned)r[1]); }
__device__ __forceinline__ float xsum32(float v) { const unsigned x = __builtin_bit_cast(unsigned, v); const auto r = __builtin_amdgcn_permlane32_swap(x, x, false, false); return __builtin_bit_cast(float, (unsigned)r[0]) + __builtin_bit_cast(float, (unsigned)r[1]); }
__device__ __forceinline__ unsigned cvt_pk_bf16(float lo, float hi) { unsigned r; asm volatile("v_cvt_pk_bf16_f32 %0, %1, %2" : "=v"(r) : "v"(lo), "v"(hi)); return r; }

template <int ACT  , bool PROD = false> struct EpiBf16 {
    static constexpr bool PERM = true, AFTER_DRAIN = false, MIDK = false;
    bf16_t* O; int ldc; const float* rstd; const float* bias; int bstride;
    int prod_pn0 = 1 << 30, prod_col0 = 0;
    __device__ __forceinline__ void operator()(const f32x4 (&acc)[2][2][4][2], const Unit& u, int wr, int wc, int fr, int fq) const {
        const int row0 = u.pm * BM + wr * 64 + fr; const int col0 = u.pn * BM + wc * 32 + 8 * fq;
        const float* bp = bias + (size_t)(u.pm < 128 ? (u.pm >> 5) : 4) * bstride + col0;
        f32x4 bv[2][2];
#pragma unroll
        for (int bj = 0; bj < 2; ++bj)
#pragma unroll
            for (int n = 0; n < 2; ++n) bv[bj][n] = *(const f32x4*)(bp + bj * HALF + 4 * n);
        float rv[2];
#pragma unroll
        for (int ai = 0; ai < 2; ++ai) rv[ai] = rstd[u.pm * BM + ai * HALF + wr * 64 + fr + 16 * fq];
        float rb[2][4];
#pragma unroll
        for (int ai = 0; ai < 2; ++ai) { const unsigned x = __builtin_bit_cast(unsigned, rv[ai]);
            const auto r16 = __builtin_amdgcn_permlane16_swap(x, x, false, false);
            const unsigned e = r16[0], o = r16[1];
            const auto pe = __builtin_amdgcn_permlane32_swap(e, e, false, false), po = __builtin_amdgcn_permlane32_swap(o, o, false, false);
            rb[ai][0] = __builtin_bit_cast(float, (unsigned)pe[0]); rb[ai][2] = __builtin_bit_cast(float, (unsigned)pe[1]);
            rb[ai][1] = __builtin_bit_cast(float, (unsigned)po[0]); rb[ai][3] = __builtin_bit_cast(float, (unsigned)po[1]); }
        const unsigned voff = (unsigned)(fr * ldc + 8 * fq) * 2u;
        if (PROD && u.pn >= prod_pn0) {
#pragma unroll
            for (int ai = 0; ai < 2; ++ai)
#pragma unroll
                for (int m = 0; m < 4; ++m) { bf16_t* rowp = (bf16_t*)((char*)(O + (size_t)(u.pm * BM + wr * 64 + ai * HALF + m * 16) * ldc + prod_col0 + 128 * (u.pn - prod_pn0) + wc * 32) + voff);
                    const float r = rb[ai][m];
                    const f32x4 p0 = (acc[ai][0][m][0] * r + bv[0][0]) * (acc[ai][1][m][0] * r + bv[1][0]), p1 = (acc[ai][0][m][1] * r + bv[0][1]) * (acc[ai][1][m][1] * r + bv[1][1]);
                    u32x4 w; w.x = cvt_pk_bf16(p0[0], p0[1]); w.y = cvt_pk_bf16(p0[2], p0[3]); w.z = cvt_pk_bf16(p1[0], p1[1]); w.w = cvt_pk_bf16(p1[2], p1[3]);
                    *(u32x4*)rowp = w; }
            return; }
#pragma unroll
        for (int ai = 0; ai < 2; ++ai)
#pragma unroll
            for (int m = 0; m < 4; ++m) { bf16_t* rowp = (bf16_t*)((char*)(O + (size_t)(u.pm * BM + wr * 64 + ai * HALF + m * 16) * ldc + u.pn * BM + wc * 32) + voff);
                const float r = rb[ai][m];
#pragma unroll
                for (int bj = 0; bj < 2; ++bj) { f32x4 v0 = acc[ai][bj][m][0] * r + bv[bj][0], v1 = acc[ai][bj][m][1] * r + bv[bj][1];
                    if (ACT == 2) {
#pragma unroll
                        for (int e = 0; e < 4; ++e) { const float a = fmaxf(v0[e], 0.f), b = fmaxf(v1[e], 0.f); v0[e] = a * a; v1[e] = b * b; } }
                    u32x4 w; w.x = cvt_pk_bf16(v0[0], v0[1]); w.y = cvt_pk_bf16(v0[2], v0[3]); w.z = cvt_pk_bf16(v1[0], v1[1]); w.w = cvt_pk_bf16(v1[2], v1[3]);
                    *(u32x4*)(rowp + bj * HALF) = w; } }
    }
};

struct EpiGateRes {
    static constexpr bool PERM = true, AFTER_DRAIN = false, MIDK = false;
    const float* base_f32; const bf16_t* base_bf; bf16_t* out; const float* gate; int ldc; int gstride;
    bf16_t* a2; float* ssq; int ssq_stride; const float* cs_g; const float* cs_sc;
    __device__ __forceinline__ void operator()(const f32x4 (&acc)[2][2][4][2], const Unit& u, int wr, int wc, int fr, int fq) const {
        const int col0 = u.pn * BM + wc * 32 + 8 * fq;
        const int mrow = u.pm >> 5;
        const float* gb = gate + (size_t)mrow * gstride + col0;
        const size_t roff = (size_t)(u.pm * BM + wr * 64 + fr) * ldc + col0;
        f32x4 gv[2][2], cv[2][2];
#pragma unroll
        for (int bj = 0; bj < 2; ++bj)
#pragma unroll
            for (int n = 0; n < 2; ++n) { gv[bj][n] = *(const f32x4*)(gb + bj * HALF + 4 * n);
                if (a2) cv[bj][n] = *(const f32x4*)(cs_g + col0 + bj * HALF + 4 * n) * (*(const f32x4*)(cs_sc + (size_t)mrow * gstride + col0 + bj * HALF + 4 * n) + 1.0f);
                else cv[bj][n] = (f32x4){0.f, 0.f, 0.f, 0.f}; }
#pragma unroll
        for (int gi = 0; gi < 8; ++gi) { const int ai = gi >> 2, m = gi & 3; const size_t off = (size_t)(ai * HALF + m * 16) * ldc;
            f32x4 bs[2][2];
            if (base_f32) {
#pragma unroll
                for (int bj = 0; bj < 2; ++bj)
#pragma unroll
                    for (int n = 0; n < 2; ++n) bs[bj][n] = *(const f32x4*)(base_f32 + roff + off + bj * HALF + 4 * n);
            } else {
#pragma unroll
                for (int bj = 0; bj < 2; ++bj) { const u32x4 r = *(const u32x4*)(base_bf + roff + off + bj * HALF);
                    bs[bj][0] = (f32x4){__uint_as_float(r.x << 16), __uint_as_float(r.x & 0xffff0000u), __uint_as_float(r.y << 16), __uint_as_float(r.y & 0xffff0000u)};
                    bs[bj][1] = (f32x4){__uint_as_float(r.z << 16), __uint_as_float(r.z & 0xffff0000u), __uint_as_float(r.w << 16), __uint_as_float(r.w & 0xffff0000u)}; }
            }
            float ss = 0.f;
#pragma unroll
            for (int bj = 0; bj < 2; ++bj) { f32x4 x[2];
#pragma unroll
                for (int n = 0; n < 2; ++n) { x[n] = bs[bj][n] + gv[bj][n] * acc[ai][bj][m][n];
                    ss += (x[n][0] * x[n][0] + x[n][1] * x[n][1]) + (x[n][2] * x[n][2] + x[n][3] * x[n][3]); }
                { u32x4 w; w.x = cvt_pk_bf16(x[0][0], x[0][1]); w.y = cvt_pk_bf16(x[0][2], x[0][3]); w.z = cvt_pk_bf16(x[1][0], x[1][1]); w.w = cvt_pk_bf16(x[1][2], x[1][3]);
                  *(u32x4*)(out + roff + off + bj * HALF) = w; }
                if (a2) { const f32x4 y0 = x[0] * cv[bj][0], y1 = x[1] * cv[bj][1];
                    u32x4 w; w.x = cvt_pk_bf16(y0[0], y0[1]); w.y = cvt_pk_bf16(y0[2], y0[3]); w.z = cvt_pk_bf16(y1[0], y1[1]); w.w = cvt_pk_bf16(y1[2], y1[3]);
                    *(u32x4*)(a2 + roff + off + bj * HALF) = w; } }
            if (a2) { ss = xsum16(ss); ss = xsum32(ss);
                if (fq == 0) ssq[(size_t)(u.pn * 4 + wc) * ssq_stride + u.pm * BM + wr * 64 + fr + ai * HALF + m * 16] = ss; }
            if (gi & 1) asm volatile("" ::: "memory"); }
    }
};
struct EpiGateResSplit {
    static constexpr bool PERM = true, AFTER_DRAIN = false, MIDK = false;
    EpiGateRes whole; float* part; int ctx_pm0; int ldc;
    __device__ __forceinline__ void operator()(const f32x4 (&acc)[2][2][4][2], const Unit& u, int wr, int wc, int fr, int fq) const {
        if (u.ks < 0) { whole(acc, u, wr, wc, fr, fq); return; }
        float* op = part + ((size_t)u.ks * 4 * BM + (size_t)(u.pm - ctx_pm0) * BM + wr * 64 + fr) * ldc + u.pn * BM + wc * 32 + 8 * fq;
#pragma unroll
        for (int ai = 0; ai < 2; ++ai)
#pragma unroll
            for (int m = 0; m < 4; ++m) { const size_t off = (size_t)(ai * HALF + m * 16) * ldc;
#pragma unroll
                for (int bj = 0; bj < 2; ++bj)
#pragma unroll
                    for (int n = 0; n < 2; ++n) *(f32x4*)(op + off + bj * HALF + 4 * n) = acc[ai][bj][m][n]; }
    }
};
struct EpiGateResSplitMid {
    static constexpr bool PERM = true, AFTER_DRAIN = false, MIDK = true;
    EpiGateResSplit base; const float* rna;
    __device__ __forceinline__ void operator()(const f32x4 (&acc)[2][2][4][2], const Unit& u, int wr, int wc, int fr, int fq) const { base(acc, u, wr, wc, fr, fq); }
    __device__ __forceinline__ void mid_load(float (&rv)[2], const Unit& u, int wr, int fr, int fq) const {
#pragma unroll
        for (int ai = 0; ai < 2; ++ai) rv[ai] = u.ks < 0 ? rna[u.pm * BM + ai * HALF + wr * 64 + fr + 16 * fq] : 1.0f; }
    __device__ __forceinline__ void mid(f32x4 (&acc)[2][2][4][2], const float (&rvv)[2]) const {
        float rb[2][4];
#pragma unroll
        for (int ai = 0; ai < 2; ++ai) { const unsigned x = __builtin_bit_cast(unsigned, rvv[ai]);
            const auto r16 = __builtin_amdgcn_permlane16_swap(x, x, false, false);
            const unsigned e = r16[0], o = r16[1];
            const auto pe = __builtin_amdgcn_permlane32_swap(e, e, false, false), po = __builtin_amdgcn_permlane32_swap(o, o, false, false);
            rb[ai][0] = __builtin_bit_cast(float, (unsigned)pe[0]); rb[ai][2] = __builtin_bit_cast(float, (unsigned)pe[1]);
            rb[ai][1] = __builtin_bit_cast(float, (unsigned)po[0]); rb[ai][3] = __builtin_bit_cast(float, (unsigned)po[1]); }
#pragma unroll
        for (int ai = 0; ai < 2; ++ai)
#pragma unroll
            for (int m = 0; m < 4; ++m)
#pragma unroll
                for (int bj = 0; bj < 2; ++bj)
#pragma unroll
                    for (int n = 0; n < 2; ++n) acc[ai][bj][m][n] = acc[ai][bj][m][n] * rb[ai][m];
    }
};

template <class Epi, class Sched, bool ALIGN_EPI = false, bool SP2 = false>
__device__ __forceinline__ void gemm_phase(PG8_LAS unsigned char* lds, const Gemm g, const Sched& S, const Epi& E, const int tid_in) {
    const int tid = tid_in, wid = __builtin_amdgcn_readfirstlane(tid >> 6), lane = tid & 63, wr = wid >> 2, wc = wid & 3, fr = lane & 15, fq = lane >> 4;
    const int K = g.K;
    unsigned voffA[2], voffB[2];
#pragma unroll
    for (int i = 0; i < 2; ++i) { int R, C; stage_rc(tid * 16 + i * 8192, R, C); const int Rb = Epi::PERM ? ((R & ~31) + perm32(R & 31)) : R;
        voffA[i] = (unsigned)(R * K + C) * 2u; voffB[i] = (unsigned)(Rb * K + C) * 2u; }
    const size_t kstep = (size_t)(BK * 2);
    const size_t hstep = (size_t)HALF * K * 2;
    const size_t tstep = 2 * hstep;
    const unsigned ldsw = (unsigned)wid * 1024u;
    const int aoff = lds_byte(wr * 64 + fr, fq * 8), boff = lds_byte(wc * 32 + fr, fq * 8);
#define PG8_SA(b, h) (((b) * 2 + (h)) * HTB)
#define PG8_SB(b, h) ((4 + (b) * 2 + (h)) * HTB)
#define PG8_STAGE(bufoff, gbase, voff) do { _Pragma("unroll") for (int _i = 0; _i < 2; ++_i) \
        __builtin_amdgcn_global_load_lds((const unsigned*)((const char*)(gbase) + (voff)[_i]), (PG8_LAS unsigned*)(lds + (bufoff) + ldsw + _i * 8192), 16, 0, 0); } while (0)
#define PG8_LDA(dst, b, h) do { _Pragma("unroll") for (int m = 0; m < 4; ++m) _Pragma("unroll") for (int k = 0; k < 2; ++k) dst[m][k] = *(const PG8_LAS bf16x8*)(lds + PG8_SA(b, h) + aoff + m * 2048 + k * 1024); } while (0)
#define PG8_LDB(dst, b, h) do { _Pragma("unroll") for (int n = 0; n < 2; ++n) _Pragma("unroll") for (int k = 0; k < 2; ++k) dst[n][k] = *(const PG8_LAS bf16x8*)(lds + PG8_SB(b, h) + boff + n * 2048 + k * 1024); } while (0)
#define PG8_MMA(ai, bj, At, Bt) do { __builtin_amdgcn_s_setprio(1); _Pragma("unroll") for (int m = 0; m < 4; ++m) _Pragma("unroll") for (int n = 0; n < 2; ++n) _Pragma("unroll") for (int k = 0; k < 2; ++k) \
        acc[ai][bj][m][n] = __builtin_amdgcn_mfma_f32_16x16x32_bf16(Bt[n][k], At[m][k], acc[ai][bj][m][n], 0, 0, 0); __builtin_amdgcn_s_setprio(0); } while (0)
#define PG8_WAIT_V(n) asm volatile("s_waitcnt vmcnt(" #n ")" ::: "memory")
#define PG8_WAIT_L(n) asm volatile("s_waitcnt lgkmcnt(" #n ")" ::: "memory")
#define PG8_BAR __builtin_amdgcn_s_barrier()
#define PG8_SCHED __builtin_amdgcn_sched_barrier(0)
    Unit cur, nxt; int ui = 0;
    if (!S.next(0, cur)) return;
    f32x4 acc[2][2][4][2];
#pragma unroll
    for (int a = 0; a < 2; ++a)
#pragma unroll
        for (int b = 0; b < 2; ++b)
#pragma unroll
            for (int m = 0; m < 4; ++m)
#pragma unroll
                for (int n = 0; n < 2; ++n) acc[a][b][m][n] = (f32x4){0.f, 0.f, 0.f, 0.f};
    bf16x8 At[4][2], B0[2][2], B1[2][2];
    const char* cA = (const char*)g.A + (size_t)cur.pm * tstep + (size_t)cur.k0 * 2; const char* cB = (const char*)g.Bt + (size_t)cur.pn * tstep + (size_t)cur.k0 * 2;
    S.a_ready(cur);
    if constexpr (SP2) {
        PG8_STAGE(PG8_SB(0, 0), cB, voffB); PG8_STAGE(PG8_SB(0, 1), cB + hstep, voffB); PG8_STAGE(PG8_SA(0, 0), cA, voffA); PG8_STAGE(PG8_SA(0, 1), cA + hstep, voffA);
        if (wr == 1) PG8_BAR;
        PG8_WAIT_V(2); PG8_BAR;
        PG8_STAGE(PG8_SB(1, 0), cB + kstep, voffB); PG8_STAGE(PG8_SA(1, 0), cA + kstep, voffA); PG8_STAGE(PG8_SB(1, 1), cB + hstep + kstep, voffB);
        PG8_WAIT_V(6); PG8_BAR;
    } else {
        PG8_STAGE(PG8_SB(0, 0), cB, voffB); PG8_STAGE(PG8_SA(0, 0), cA, voffA); PG8_STAGE(PG8_SB(0, 1), cB + hstep, voffB); PG8_STAGE(PG8_SA(0, 1), cA + hstep, voffA);
        if (wr == 1) PG8_BAR;
        PG8_WAIT_V(4); PG8_BAR;
        PG8_STAGE(PG8_SB(1, 0), cB + kstep, voffB); PG8_STAGE(PG8_SA(1, 0), cA + kstep, voffA); PG8_STAGE(PG8_SB(1, 1), cB + hstep + kstep, voffB);
        PG8_WAIT_V(6); PG8_BAR;
    }
    for (;;) {
        const bool has_next = S.next(ui + 1, nxt);
        const char* nA = has_next ? (const char*)g.A + (size_t)nxt.pm * tstep + (size_t)nxt.k0 * 2 : cA; const char* nB = has_next ? (const char*)g.Bt + (size_t)nxt.pn * tstep + (size_t)nxt.k0 * 2 : cB;
        const int nt = cur.nt;
        const int npass = Epi::MIDK ? 2 : 1;
        float mrv[2] = {1.0f, 1.0f};
        if constexpr (Epi::MIDK) E.mid_load(mrv, cur, wr, fr, fq);
#pragma unroll 1
        for (int ps = 0; ps < npass; ++ps) {
        const int t_lo = (Epi::MIDK && ps == 1) ? nt / 2 : 0, t_hi = (Epi::MIDK && ps == 0) ? nt / 2 : nt;
        for (int t = t_lo; t < t_hi; t += 2) {
            const bool last = (t == nt - 2);
            const char* a1 = cA + (size_t)(t + 1) * kstep;
            const char* a2 = last ? nA : cA + (size_t)(t + 2) * kstep; const char* b2 = last ? nB : cB + (size_t)(t + 2) * kstep;
            const char* a3 = a2 + kstep; const char* b3 = b2 + kstep;
            if (last && has_next) S.a_ready(nxt);
            if constexpr (SP2) {
            PG8_LDB(B0, 0, 0); PG8_LDB(B1, 0, 1); PG8_SCHED; PG8_LDA(At, 0, 0); PG8_STAGE(PG8_SA(1, 1), a1 + hstep, voffA);
            PG8_WAIT_V(8); PG8_WAIT_L(0); PG8_BAR; PG8_MMA(0, 0, At, B0); PG8_MMA(0, 1, At, B1); PG8_BAR; PG8_SCHED;
            PG8_LDA(At, 0, 1); PG8_STAGE(PG8_SB(0, 0), b2, voffB); PG8_STAGE(PG8_SB(0, 1), b2 + hstep, voffB); PG8_STAGE(PG8_SA(0, 0), a2, voffA);
            PG8_WAIT_V(8); PG8_WAIT_L(0); PG8_BAR; PG8_MMA(1, 0, At, B0); PG8_MMA(1, 1, At, B1); PG8_BAR; PG8_SCHED;
            PG8_LDB(B0, 1, 0); PG8_LDB(B1, 1, 1); PG8_SCHED; PG8_LDA(At, 1, 0); PG8_STAGE(PG8_SA(0, 1), a2 + hstep, voffA);
            PG8_WAIT_V(8); PG8_WAIT_L(0); PG8_BAR; PG8_MMA(0, 0, At, B0); PG8_MMA(0, 1, At, B1); PG8_BAR; PG8_SCHED;
            PG8_LDA(At, 1, 1); PG8_STAGE(PG8_SB(1, 0), b3, voffB); PG8_STAGE(PG8_SB(1, 1), b3 + hstep, voffB); PG8_STAGE(PG8_SA(1, 0), a3, voffA);
            PG8_WAIT_V(8); PG8_WAIT_L(0); PG8_BAR; PG8_MMA(1, 0, At, B0); PG8_MMA(1, 1, At, B1); PG8_BAR; PG8_SCHED;
            } else {
            PG8_LDB(B0, 0, 0); PG8_SCHED; PG8_LDA(At, 0, 0); PG8_STAGE(PG8_SA(1, 1), a1 + hstep, voffA);
            PG8_WAIT_L(8); PG8_BAR; PG8_WAIT_L(0); PG8_MMA(0, 0, At, B0); PG8_BAR; PG8_SCHED;
            PG8_LDB(B1, 0, 1); PG8_STAGE(PG8_SB(0, 0), b2, voffB);
            PG8_BAR; PG8_WAIT_L(0); PG8_MMA(0, 1, At, B1); PG8_BAR;
            PG8_LDA(At, 0, 1); PG8_STAGE(PG8_SA(0, 0), a2, voffA);
            PG8_BAR; PG8_WAIT_L(0); PG8_MMA(1, 0, At, B0); PG8_BAR; PG8_SCHED;
            PG8_STAGE(PG8_SB(0, 1), b2 + hstep, voffB);
            PG8_WAIT_V(6); PG8_BAR; PG8_MMA(1, 1, At, B1); PG8_BAR;
            PG8_LDB(B0, 1, 0); PG8_SCHED; PG8_LDA(At, 1, 0); PG8_STAGE(PG8_SA(0, 1), a2 + hstep, voffA);
            PG8_WAIT_L(8); PG8_BAR; PG8_WAIT_L(0); PG8_MMA(0, 0, At, B0); PG8_BAR; PG8_SCHED;
            PG8_LDB(B1, 1, 1); PG8_STAGE(PG8_SB(1, 0), b3, voffB);
            PG8_BAR; PG8_WAIT_L(0); PG8_MMA(0, 1, At, B1); PG8_BAR;
            PG8_LDA(At, 1, 1); PG8_STAGE(PG8_SA(1, 0), a3, voffA);
            PG8_BAR; PG8_WAIT_L(0); PG8_MMA(1, 0, At, B0); PG8_BAR; PG8_SCHED;
            PG8_STAGE(PG8_SB(1, 1), b3 + hstep, voffB);
            PG8_WAIT_V(6); PG8_BAR; PG8_MMA(1, 1, At, B1); PG8_BAR;
            }
        }
        if constexpr (Epi::MIDK) { if (ps == 0) E.mid(acc, mrv); }
        }
        if constexpr (ALIGN_EPI) { if (wr == 0) PG8_BAR; }
        if constexpr (!Epi::AFTER_DRAIN) { E(acc, cur, wr, wc, fr, fq); S.done(cur); }
        if (!has_next) break;
#pragma unroll
        for (int a = 0; a < 2; ++a)
#pragma unroll
            for (int b = 0; b < 2; ++b)
#pragma unroll
                for (int m = 0; m < 4; ++m)
#pragma unroll
                    for (int n = 0; n < 2; ++n) acc[a][b][m][n] = (f32x4){0.f, 0.f, 0.f, 0.f};
        cur = nxt; cA = nA; cB = nB; ++ui;
        if constexpr (ALIGN_EPI) { if (wr == 1) PG8_BAR; }
    }
    PG8_WAIT_V(0);
    if constexpr (!ALIGN_EPI) { if (wr == 0) PG8_BAR; }
    PG8_BAR;
    if constexpr (Epi::AFTER_DRAIN) { E.fused(acc, cur, wr, wc, fr, fq, lds, wid, lane); S.done(cur); }
#undef PG8_SA
#undef PG8_SB
#undef PG8_STAGE
#undef PG8_LDA
#undef PG8_LDB
#undef PG8_MMA
#undef PG8_WAIT_V
#undef PG8_WAIT_L
#undef PG8_BAR
#undef PG8_SCHED
}
}

constexpr int NWAVES = 8;
#ifndef MK_PER_PHASE
#define MK_PER_PHASE 0
#endif

constexpr int DM = 2048, NB = 4, SEQ = 8192, DEPTH = 4, CTXL = 256, GRID_W = 64, GRID_R = SEQ / GRID_W;
constexpr int NAW = 1024, NH = 8, HD = 128, CVW = 1024, INC = 6144, DFF = 8192, NMOD = 6, MODW = NMOD * DM;
constexpr int WIN_R = 8, WIN_C = 16, RPB_R = 2 * WIN_R - 1, RPB_C = 2 * WIN_C - 1, RPB_HS = RPB_R * RPB_C;
constexpr int MLAT = NB * SEQ, MCTX = NB * CTXL, MT = MLAT + MCTX;
constexpr float EPS = 1e-6f;
constexpr int COL_Q = 0, COL_K = NAW, COL_V = 2 * NAW, COL_BG = 3 * NAW, COL_CG = 3 * NAW + CVW, COL_U = 3 * NAW + 2 * CVW;
constexpr int PPITCH = INC + 64;
constexpr int N_PHASES = 2 + 7 * DEPTH;

constexpr size_t MiB = 1u << 20;
constexpr size_t WS_CTL = 0, CTL_ZERO_BYTES = 1 * MiB;
constexpr size_t WS_MOD = 1 * MiB;
constexpr size_t WS_VEC = 2 * MiB;
constexpr size_t WS_WIN = 3 * MiB, WS_WOUT = 99 * MiB, WS_W1 = 131 * MiB, WS_W2 = 259 * MiB;
constexpr size_t WS_X = 387 * MiB;
constexpr size_t WS_XN = 651 * MiB;
constexpr size_t WS_P = 783 * MiB;
constexpr size_t WS_MIX = 1184 * MiB;
constexpr size_t WS_H = 783 * MiB;
constexpr size_t WS_PO = 1316 * MiB, WS_PM = 1380 * MiB;
constexpr size_t WS_SSQ = 1444 * MiB, SSQ_BYTES = 2 * MiB;
constexpr size_t WS_SHW = 1446 * MiB;
constexpr size_t WS_SSQP = 1448 * MiB;
constexpr size_t WS_END = 1454 * MiB;
constexpr int NSPLIT = 8;
constexpr int VEC_G1 = 0, VEC_G2 = DM, VEC_RPB = 2 * DM, VEC_CW = VEC_RPB + 3728, VEC_GNA = VEC_CW + 3 * CVW, VEC_GCV = VEC_GNA + NAW, VEC_L = VEC_GCV + CVW, VEC_GF = DEPTH * VEC_L;
static_assert(NH * RPB_HS <= 3728 && (size_t)(VEC_GF + DM) * 4 <= MiB && VEC_CW % 4 == 0 && VEC_L % 4 == 0, "VEC map");
static_assert((size_t)DEPTH * 5 * MODW * 4 <= MiB && WS_WIN + (size_t)DEPTH * INC * DM * 2 <= WS_WOUT && WS_WOUT + (size_t)DEPTH * DM * DM * 2 <= WS_W1 && WS_W1 + (size_t)DEPTH * DFF * DM * 2 <= WS_W2 &&
              WS_W2 + (size_t)DEPTH * DFF * DM * 2 <= WS_X && WS_X + (size_t)MT * DM * 4 <= WS_XN && WS_XN + (size_t)MT * DM * 2 <= WS_P && WS_P + (size_t)MT * PPITCH * 2 <= WS_MIX &&
              WS_MIX + (size_t)MT * DM * 2 <= WS_PO && WS_H + (size_t)MT * DFF * 2 <= WS_PO && WS_PO + (size_t)NSPLIT * MCTX * DM * 4 <= WS_PM && WS_PM + (size_t)NSPLIT * MCTX * DM * 4 <= WS_SSQ && (size_t)DEPTH * 2 * MT * 4 <= SSQ_BYTES && WS_SHW + (size_t)DEPTH * 5 * (INC + DFF) * 4 <= WS_SSQP && WS_SSQP + (size_t)32 * MT * 4 <= WS_END, "d_ws map");
constexpr int CW_BAR = 4096;

constexpr int RING_OFF = 0, RING_BYTES = 131072;
constexpr int LDSCTL_OFF = RING_BYTES, MISC_OFF = LDSCTL_OFF + 320;
constexpr int LDS_BYTES = 147456;
static_assert(MISC_OFF + 128 <= LDS_BYTES, "LDS map");

#define GAS __attribute__((address_space(1)))
#define LAS __attribute__((address_space(3)))
typedef unsigned short bf16;
typedef unsigned v4u __attribute__((ext_vector_type(4)));
typedef float f32x4 __attribute__((ext_vector_type(4)));
typedef short bf16x8 __attribute__((ext_vector_type(8)));
typedef GAS unsigned gu32;
typedef GAS unsigned long long gu64;
#define RLX_AGENT __ATOMIC_RELAXED, __HIP_MEMORY_SCOPE_AGENT
#define LDS_WAIT() asm volatile("s_waitcnt lgkmcnt(0)" ::: "memory")
#define VM_WAIT() asm volatile("s_waitcnt vmcnt(0)" ::: "memory")
__device__ __forceinline__ unsigned long long rt() { return __builtin_amdgcn_s_memrealtime(); }
__device__ __forceinline__ unsigned f2bf(float f) { unsigned u = __builtin_bit_cast(unsigned, f); return (u + 0x7fffu + ((u >> 16) & 1u)) >> 16; }
__device__ __forceinline__ unsigned pk2(float lo, float hi) { return f2bf(lo) | (f2bf(hi) << 16); }

#define XB_TMO      128
#define XB_XCNT(j)  (256  + 64 * (j))
#define XB_XSUB(j)  (1280 + 64 * (j))
#define XB_XGEN(j)  (2304 + 64 * (j))
#define XB_TOP      3328
#define XB_TOPGEN   3392
#define XCD_BAR_WORDS 3456
#define XB_SPIN_CAP (1u << 18)

__device__ __forceinline__ unsigned xb_ld(unsigned* p)              { return __hip_atomic_load(p, __ATOMIC_RELAXED, __HIP_MEMORY_SCOPE_AGENT); }
__device__ __forceinline__ unsigned xb_add(unsigned* p, unsigned v) { return __hip_atomic_fetch_add(p, v, __ATOMIC_RELAXED, __HIP_MEMORY_SCOPE_AGENT); }
__device__ __forceinline__ unsigned xb_xcc_id() { return (unsigned)__builtin_amdgcn_s_getreg((3 << 11) | 20) & 0xFu; }
#define XB_SPIN(cond, bar) do { unsigned _sp = 0; while (cond) { __builtin_amdgcn_s_sleep(1); \
    if ((++_sp & 255u) == 0u) { if (xb_ld(&(bar)[XB_TMO])) break; if (_sp > XB_SPIN_CAP) { atomicAdd(&(bar)[XB_TMO], 1u); break; } } } } while (0)

struct XcdBarrier {
    unsigned* bar; unsigned x;
    volatile LAS unsigned* st;
};

__device__ __forceinline__ XcdBarrier xcd_barrier_post(unsigned* bar, volatile LAS unsigned* st) {
    XcdBarrier b; b.bar = bar; b.x = xb_xcc_id(); b.st = st;
    if (threadIdx.x == 0) (void)xb_add(&bar[XB_XCNT(b.x)], 1u);
    return b;
}
__device__ __forceinline__ void xcd_barrier_complete(unsigned* bar, unsigned x, unsigned& nloc, unsigned& nx) {
    const unsigned G = gridDim.x * gridDim.y * gridDim.z;
    unsigned sum, cnt, mine, sp = 0u;
    for (;;) {
        sum = 0u; cnt = 0u; mine = 0u;
#pragma unroll
        for (unsigned j = 0; j < 16; ++j) { const unsigned c = xb_ld(&bar[XB_XCNT(j)]); sum += c; cnt += (c > 0u) ? 1u : 0u; mine = (j == x) ? c : mine; }
        if (sum == G) break;
        __builtin_amdgcn_s_sleep(1);
        if ((++sp & 255u) == 0u) { if (xb_ld(&bar[XB_TMO])) break; if (sp > XB_SPIN_CAP) { atomicAdd(&bar[XB_TMO], 1u); break; } }
    }
    nloc = mine > 0u ? mine : 1u; nx = cnt > 0u ? cnt : 1u;
}

__device__ __forceinline__ void xcd_barrier(const XcdBarrier& b) {
    asm volatile("s_waitcnt vmcnt(0)" ::: "memory");
    __syncthreads();
    if (threadIdx.x == 0) {
        unsigned* bar = b.bar;
        __builtin_amdgcn_s_waitcnt(0);
        unsigned nloc = b.st[0], nx = b.st[1];
        if (nloc == 0u) { xcd_barrier_complete(bar, b.x, nloc, nx); b.st[0] = nloc; b.st[1] = nx; }
        const unsigned old = xb_add(&bar[XB_XSUB(b.x)], 1u);
        const unsigned gen = old / nloc;
        if (old + 1u == (gen + 1u) * nloc) {
            __builtin_amdgcn_fence(__ATOMIC_RELEASE, "agent");
            asm volatile("s_waitcnt vmcnt(0)" ::: "memory");
            const unsigned og = xb_add(&bar[XB_TOP], 1u);
            const unsigned tg = og / nx;
            if (og + 1u == (tg + 1u) * nx) xb_add(&bar[XB_TOPGEN], 1u);
            else XB_SPIN(xb_ld(&bar[XB_TOPGEN]) == tg, bar);
            __builtin_amdgcn_fence(__ATOMIC_ACQUIRE, "agent");
            xb_add(&bar[XB_XGEN(b.x)], 1u);
            asm volatile("s_waitcnt vmcnt(0)" ::: "memory");
        } else {
            XB_SPIN(xb_ld(&bar[XB_XGEN(b.x)]) == gen, bar);
            __builtin_amdgcn_fence(__ATOMIC_ACQUIRE, "agent");
            asm volatile("s_waitcnt vmcnt(0)" ::: "memory");
        }
    }
    __syncthreads();
}

struct Frame {
    LAS unsigned char* lds;
    volatile LAS unsigned* MISC;
    gu32* ctl;
    int tid, lane, wave;
    int vcu, G;
};
typedef unsigned u32x2 __attribute__((ext_vector_type(2)));
typedef short v4i16_t __attribute__((ext_vector_type(4)));
typedef float f32x4v __attribute__((ext_vector_type(4)));

template <int CTRL> __device__ __forceinline__ float dpp_mov(float v) { return __uint_as_float(__builtin_amdgcn_update_dpp(0u, __float_as_uint(v), CTRL, 0xF, 0xF, true)); }
__device__ __forceinline__ float x16_sum(float v) { const unsigned x = __float_as_uint(v); const auto r = __builtin_amdgcn_permlane16_swap(x, x, false, false); return __uint_as_float(r[0]) + __uint_as_float(r[1]); }
__device__ __forceinline__ float x32_sum(float v) { const unsigned x = __float_as_uint(v); const auto r = __builtin_amdgcn_permlane32_swap(x, x, false, false); return __uint_as_float(r[0]) + __uint_as_float(r[1]); }
__device__ __forceinline__ float x16_max(float v) { const unsigned x = __float_as_uint(v); const auto r = __builtin_amdgcn_permlane16_swap(x, x, false, false); return fmaxf(__uint_as_float(r[0]), __uint_as_float(r[1])); }
__device__ __forceinline__ float x32_max(float v) { const unsigned x = __float_as_uint(v); const auto r = __builtin_amdgcn_permlane32_swap(x, x, false, false); return fmaxf(__uint_as_float(r[0]), __uint_as_float(r[1])); }
__device__ __forceinline__ float wave_sum(float v) {
    v += dpp_mov<0xB1>(v);
    v += dpp_mov<0x4E>(v);
    v += dpp_mov<0x141>(v);
    v += dpp_mov<0x140>(v);
    return x32_sum(x16_sum(v));
}
__device__ __forceinline__ float bf_lo(unsigned w) { return __uint_as_float(w << 16); }
__device__ __forceinline__ float bf_hi(unsigned w) { return __uint_as_float(w & 0xffff0000u); }

struct P0Item { const float* W; bf16* WT; const float* kscale; int K, N, k0, n0, s0; };
__device__ __forceinline__ P0Item p0_item(const float* W, int K, int N, bf16* WT, int item, bool cgu, const float* kscale) {
    const int nblk = N / 32, kb = item / nblk, nb = item % nblk, k0 = 64 * kb, n0 = 32 * nb;
    int s0 = n0;
    if (cgu && n0 >= COL_CG) { const int t = (n0 - COL_CG) >> 8, c = (n0 - COL_CG) & 255; s0 = c < 128 ? COL_CG + 128 * t + c : COL_U + 128 * t + (c - 128); }
    return P0Item{W, WT, (kscale && k0 < NAW) ? kscale : (const float*)nullptr, K, N, k0, n0, s0};
}
__device__ __forceinline__ void p0_load(float (&wv)[32], const P0Item& d, int lane) {
#pragma unroll
    for (int i = 0; i < 32; ++i) { const int kk = 2 * i + (lane >> 5); wv[i] = d.W[(size_t)(d.k0 + kk) * d.N + d.s0 + (lane & 31)]; }
}
__device__ __forceinline__ void p0_process(const float (&wv)[32], const P0Item& d, LAS float* scr, int lane) {
#pragma unroll
    for (int i = 0; i < 32; ++i) { const int kk = 2 * i + (lane >> 5); float v = wv[i]; if (d.kscale) v *= d.kscale[d.k0 + kk]; scr[kk * 33 + (lane & 31)] = v; }
    LDS_WAIT(); asm volatile("" ::: "memory");
    const int c = lane & 7;
#pragma unroll
    for (int j = 0; j < 4; ++j) { const int n = (lane >> 3) + 8 * j; const LAS float* s = scr + (8 * c) * 33 + n;
        v4u o; o.x = pk2(s[0 * 33], s[1 * 33]); o.y = pk2(s[2 * 33], s[3 * 33]); o.z = pk2(s[4 * 33], s[5 * 33]); o.w = pk2(s[6 * 33], s[7 * 33]);
        *(GAS v4u*)(d.WT + (size_t)(d.n0 + n) * d.K + d.k0 + 8 * c) = o; }
    LDS_WAIT(); asm volatile("" ::: "memory");
}
struct ProIn { const float *c, *c_ctx, *w_ada, *b_ada, *w_in, *w_out, *w1, *w2, *g1, *g2, *rpb, *cw, *gna, *gcv, *gf; float* mod; float* vec; bf16 *win_t, *wout_t, *w1_t, *w2_t; };
__device__ __forceinline__ void p0_prologue(Frame& F, const ProIn& I) {
    LAS float* S = (LAS float*)(F.lds + RING_OFF);
    LAS float* RED = S + 5 * DM;
    for (int i = F.tid; i < 5 * DM; i += NWAVES * 64) { const int r = i / DM, k = i % DM; const float v = r < 4 ? I.c[r * DM + k] : I.c_ctx[k]; S[i] = v / (1.0f + __expf(-v)); }
    __syncthreads();
    constexpr int NSLAB = DEPTH * (MODW / 64);
    for (int slab = blockIdx.x; slab < NSLAB; slab += F.G) {
        const int l = slab / (MODW / 64), n0 = (slab % (MODW / 64)) * 64;
        const float* wp = I.w_ada + (size_t)l * DM * MODW + (size_t)(F.wave * 256) * MODW + n0 + F.lane;
        float a0 = 0.f, a1 = 0.f, a2 = 0.f, a3 = 0.f, a4 = 0.f;
        const LAS float* s0 = S + F.wave * 256;
#pragma unroll 32
        for (int k = 0; k < 256; ++k) { const float w = wp[(size_t)k * MODW];
            a0 += s0[k] * w; a1 += s0[DM + k] * w; a2 += s0[2 * DM + k] * w; a3 += s0[3 * DM + k] * w; a4 += s0[4 * DM + k] * w; }
        LAS float* rd = RED + F.wave * 320 + F.lane;
        rd[0] = a0; rd[64] = a1; rd[128] = a2; rd[192] = a3; rd[256] = a4;
        __syncthreads();
        if (F.tid < 320) { float s = 0.f;
#pragma unroll
            for (int w = 0; w < 8; ++w) s += RED[w * 320 + F.tid];
            const int r = F.tid >> 6, n = n0 + (F.tid & 63);
            I.mod[((size_t)l * 5 + r) * MODW + n] = s + I.b_ada[(size_t)l * MODW + n]; }
        __syncthreads();
    }
    __syncthreads();
    { const int gt = blockIdx.x * (NWAVES * 64) + F.tid, NGT = F.G * NWAVES * 64;
      for (int i = gt; i < DEPTH * VEC_L + DM; i += NGT) {
          float v;
          if (i >= VEC_GF) v = I.gf[i - VEC_GF];
          else { const int l = i / VEC_L, r = i % VEC_L;
              if (r < VEC_G2) v = I.g1[l * DM + r];
              else if (r < VEC_RPB) v = I.g2[l * DM + r - VEC_G2];
              else if (r < VEC_CW) v = (r - VEC_RPB) < NH * RPB_HS ? I.rpb[l * NH * RPB_HS + r - VEC_RPB] : 0.f;
              else if (r < VEC_GNA) v = I.cw[l * 3 * CVW + r - VEC_CW];
              else if (r < VEC_GCV) v = I.gna[l * NAW + r - VEC_GNA];
              else v = I.gcv[l * CVW + r - VEC_GCV]; }
          I.vec[i] = v; } }
    LAS float* scr = (LAS float*)(F.lds + RING_OFF + F.wave * 16384);
    const int gw = F.vcu * NWAVES + F.wave, NGW = F.G * NWAVES;
    constexpr int I_IN = (DM / 64) * (INC / 32), I_OUT = (DM / 64) * (DM / 32), I_1 = (DM / 64) * (DFF / 32), I_2 = (DFF / 64) * (DM / 32);
    constexpr int I_L = I_IN + I_OUT + I_1 + I_2, NITEMS = DEPTH * I_L;
    auto item_of = [&](int it) -> P0Item {
        const int l = it / I_L; int r = it % I_L;
        if (r < I_IN) return p0_item(I.w_in + (size_t)l * DM * INC, DM, INC, I.win_t + (size_t)l * INC * DM, r, true, nullptr);
        r -= I_IN;
        if (r < I_OUT) return p0_item(I.w_out + (size_t)l * DM * DM, DM, DM, I.wout_t + (size_t)l * DM * DM, r, false, I.gna + (size_t)l * NAW);
        r -= I_OUT;
        if (r < I_1) return p0_item(I.w1 + (size_t)l * DM * DFF, DM, DFF, I.w1_t + (size_t)l * DFF * DM, r, false, nullptr);
        r -= I_1;
        return p0_item(I.w2 + (size_t)l * DFF * DM, DFF, DM, I.w2_t + (size_t)l * DM * DFF, r, false, nullptr); };
    float wa[32], wb[32];
    P0Item d0 = item_of(min(gw, NITEMS - 1));
    p0_load(wa, d0, F.lane);
#pragma unroll 1
    for (int it = gw; it < NITEMS; it += 2 * NGW) {
        const int i1 = it + NGW, i2 = it + 2 * NGW;
        const P0Item d1 = item_of(min(i1, NITEMS - 1));
        p0_load(wb, d1, F.lane);
        p0_process(wa, d0, scr, F.lane);
        const P0Item d2 = item_of(min(i2, NITEMS - 1));
        p0_load(wa, d2, F.lane);
        if (i1 < NITEMS) p0_process(wb, d1, scr, F.lane);
        d0 = d2;
    }
}

__device__ __forceinline__ void norm_prep_phase(Frame& F, const float* src_lat, const float* src_ctx, const bf16* src_ctx_bf, const float* g, const float* sc_base, bf16* A2, float* ssq, int row_lo, int nrows,
                                                const float* part, const float* gate_ctx, bf16* ctx_out, const float* ssqh) {
    const int gw = F.vcu * NWAVES + F.wave, NGW = F.G * NWAVES;
    for (int row = row_lo + gw; row < nrows; row += NGW) {
        const bool lat = row < MLAT;
        const float* sc = sc_base + (size_t)(lat ? (row >> 13) : 4) * MODW;
        f32x4v v[8]; float ss = 0.f;
        if (lat || src_ctx) { const float* xr = lat ? src_lat + (size_t)row * DM : src_ctx + (size_t)(row - MLAT) * DM;
#pragma unroll
            for (int j = 0; j < 8; ++j) v[j] = *(const f32x4v*)(xr + 256 * j + 4 * F.lane); }
        else { const bf16* xb = src_ctx_bf + (size_t)(row - MLAT) * DM;
#pragma unroll
            for (int j = 0; j < 8; ++j) { const u32x2 r = *(const u32x2*)(xb + 256 * j + 4 * F.lane); v[j] = (f32x4v){bf_lo(r.x), bf_hi(r.x), bf_lo(r.y), bf_hi(r.y)}; } }
        if (!lat && part) {
            const float* pr = part + (size_t)(row - MLAT) * DM + 4 * F.lane;
            float na_scale = 1.0f;
            if (ssqh) { const float* sp = ssqh + (size_t)(row - MLAT) * NH; float t = 0.f;
#pragma unroll
                for (int hh = 0; hh < NH; ++hh) t += sp[hh];
                na_scale = rsqrtf(t * (1.0f / NAW) + EPS); }
#pragma unroll
            for (int j = 0; j < 8; ++j) { f32x4v a = *(const f32x4v*)(pr + 256 * j);
#pragma unroll
                for (int s = 1; s < NSPLIT / 2; ++s) a += *(const f32x4v*)(pr + (size_t)s * MCTX * DM + 256 * j);
                a = a * na_scale;
#pragma unroll
                for (int s = NSPLIT / 2; s < NSPLIT; ++s) a += *(const f32x4v*)(pr + (size_t)s * MCTX * DM + 256 * j);
                v[j] += *(const f32x4v*)(gate_ctx + 256 * j + 4 * F.lane) * a;
                { u32x2 o; o.x = pk2(v[j].x, v[j].y); o.y = pk2(v[j].z, v[j].w); *(u32x2*)(ctx_out + (size_t)(row - MLAT) * DM + 256 * j + 4 * F.lane) = o; } }
        }
#pragma unroll
        for (int j = 0; j < 8; ++j) { ss += (v[j].x * v[j].x + v[j].y * v[j].y) + (v[j].z * v[j].z + v[j].w * v[j].w);
            const int c = 256 * j + 4 * F.lane;
            const f32x4v y = v[j] * (*(const f32x4v*)(g + c)) * (*(const f32x4v*)(sc + c) + 1.0f);
            u32x2 o; o.x = pk2(y.x, y.y); o.y = pk2(y.z, y.w);
            *(u32x2*)(A2 + (size_t)row * DM + c) = o; }
        ss = wave_sum(ss);
        if (F.lane == 0) ssq[row] = rsqrtf(ss * (1.0f / DM) + EPS);
    }
}
__device__ __forceinline__ void norm_prep0_phase(Frame& F, const float* src_lat, const float* src_ctx, const float* g, const float* sc_base, bf16* A2, float* ssq) {
    const int gw = F.vcu * NWAVES + F.wave, NGW = F.G * NWAVES;
    for (int row = gw; row < MT; row += 2 * NGW) {
        const int rowb = row + NGW; const bool has1 = rowb < MT; const int row1 = has1 ? rowb : row;
        const float* x0 = row < MLAT ? src_lat + (size_t)row * DM : src_ctx + (size_t)(row - MLAT) * DM;
        const float* x1 = row1 < MLAT ? src_lat + (size_t)row1 * DM : src_ctx + (size_t)(row1 - MLAT) * DM;
        f32x4v v0[8], v1[8];
#pragma unroll
        for (int j = 0; j < 8; ++j) v0[j] = *(const f32x4v*)(x0 + 256 * j + 4 * F.lane);
#pragma unroll
        for (int j = 0; j < 8; ++j) v1[j] = *(const f32x4v*)(x1 + 256 * j + 4 * F.lane);
        const float* sc0 = sc_base + (size_t)(row < MLAT ? (row >> 13) : 4) * MODW; const float* sc1 = sc_base + (size_t)(row1 < MLAT ? (row1 >> 13) : 4) * MODW;
        float s0 = 0.f, s1 = 0.f;
#pragma unroll
        for (int j = 0; j < 8; ++j) { const int c = 256 * j + 4 * F.lane; const f32x4v gg = *(const f32x4v*)(g + c);
            s0 += (v0[j].x * v0[j].x + v0[j].y * v0[j].y) + (v0[j].z * v0[j].z + v0[j].w * v0[j].w);
            s1 += (v1[j].x * v1[j].x + v1[j].y * v1[j].y) + (v1[j].z * v1[j].z + v1[j].w * v1[j].w);
            const f32x4v y0 = v0[j] * gg * (*(const f32x4v*)(sc0 + c) + 1.0f), y1 = v1[j] * gg * (*(const f32x4v*)(sc1 + c) + 1.0f);
            u32x2 o0, o1; o0.x = pk2(y0.x, y0.y); o0.y = pk2(y0.z, y0.w); o1.x = pk2(y1.x, y1.y); o1.y = pk2(y1.z, y1.w);
            *(u32x2*)(A2 + (size_t)row * DM + c) = o0;
            if (has1) *(u32x2*)(A2 + (size_t)row1 * DM + c) = o1; }
        s0 = wave_sum(s0); s1 = wave_sum(s1);
        if (F.lane == 0) { ssq[row] = rsqrtf(s0 * (1.0f / DM) + EPS); if (has1) ssq[row1] = rsqrtf(s1 * (1.0f / DM) + EPS); }
    }
}
__device__ __forceinline__ void ctx_norm_phase(Frame& F, const float* src_ctx, const bf16* src_ctx_bf, const float* g, const float* sc_base, bf16* A2, float* ssq,
                                               const float* part, const float* gate_ctx, bf16* ctx_out, const float* ssqh) {
    LAS float* red = (LAS float*)(F.lds + RING_OFF);
    const float* sc = sc_base + (size_t)4 * MODW;
    const int hf = F.wave >> 2, cb = 1024 * hf + 4 * F.lane;
    __syncthreads();
    for (int rr = F.vcu * 4 + (F.wave & 3); rr < MCTX; rr += 4 * F.G) {
        const int row = MLAT + rr;
        f32x4v v[4];
        if (src_ctx) {
#pragma unroll
            for (int j = 0; j < 4; ++j) v[j] = *(const f32x4v*)(src_ctx + (size_t)rr * DM + cb + 256 * j); }
        else {
#pragma unroll
            for (int j = 0; j < 4; ++j) { const u32x2 r = *(const u32x2*)(src_ctx_bf + (size_t)rr * DM + cb + 256 * j); v[j] = (f32x4v){bf_lo(r.x), bf_hi(r.x), bf_lo(r.y), bf_hi(r.y)}; } }
        float na_scale = 1.0f;
        if (ssqh) { const float* sp = ssqh + (size_t)rr * NH; float t = 0.f;
#pragma unroll
            for (int hh = 0; hh < NH; ++hh) t += sp[hh];
            na_scale = rsqrtf(t * (1.0f / NAW) + EPS); }
        const float* pr = part + (size_t)rr * DM + cb;
        float ss = 0.f;
        f32x4v pa[2][NSPLIT];
#pragma unroll
        for (int j = 0; j < 4; ++j) {
            if ((j & 1) == 0) {
#pragma unroll
                for (int jj = 0; jj < 2; ++jj)
#pragma unroll
                    for (int s = 0; s < NSPLIT; ++s) pa[jj][s] = *(const f32x4v*)(pr + (size_t)s * MCTX * DM + 256 * (j + jj));
                asm volatile("" ::: "memory"); }
            f32x4v a = pa[j & 1][0];
#pragma unroll
            for (int s = 1; s < NSPLIT / 2; ++s) a += pa[j & 1][s];
            a = a * na_scale;
#pragma unroll
            for (int s = NSPLIT / 2; s < NSPLIT; ++s) a += pa[j & 1][s];
            const int c = cb + 256 * j;
            v[j] += *(const f32x4v*)(gate_ctx + c) * a;
            { u32x2 o; o.x = pk2(v[j].x, v[j].y); o.y = pk2(v[j].z, v[j].w); *(u32x2*)(ctx_out + (size_t)rr * DM + c) = o; }
            ss += (v[j].x * v[j].x + v[j].y * v[j].y) + (v[j].z * v[j].z + v[j].w * v[j].w);
            const f32x4v y = v[j] * (*(const f32x4v*)(g + c)) * (*(const f32x4v*)(sc + c) + 1.0f);
            u32x2 o; o.x = pk2(y.x, y.y); o.y = pk2(y.z, y.w);
            *(u32x2*)(A2 + (size_t)row * DM + c) = o; }
        ss = wave_sum(ss);
        if (F.lane == 0) red[F.wave] = ss;
        __syncthreads();
        if (hf == 0 && F.lane == 0) ssq[row] = rsqrtf((red[F.wave] + red[F.wave + 4]) * (1.0f / DM) + EPS);
        __syncthreads();
    }
}
__device__ __forceinline__ void ssq_reduce_phase(Frame& F, const float* ssqp, float* ssq, int nrows) {
    const int gt = F.vcu * (NWAVES * 64) + F.tid, NGT = F.G * NWAVES * 64;
    for (int it = gt; it < 4 * nrows; it += NGT) { const int row = it >> 2, q = it & 3; float s = 0.f;
#pragma unroll
        for (int k = 0; k < 8; ++k) s += ssqp[(size_t)(8 * q + k) * MT + row];
        s += dpp_mov<0xB1>(s); s += dpp_mov<0x4E>(s);
        if (q == 0) ssq[row] = rsqrtf(s * (1.0f / DM) + EPS); }
}
__device__ __forceinline__ void shw_phase(Frame& F, const bf16* WT, const float* sh_base, float* shw, int N, int cu_rank, int n_cus) {
    LAS float* SH = (LAS float*)(F.lds + RING_OFF);
    __syncthreads();
    for (int i = F.tid; i < 5 * DM; i += NWAVES * 64) SH[i] = sh_base[(size_t)(i / DM) * MODW + (i % DM)];
    __syncthreads();
    const int gw = cu_rank * NWAVES + F.wave, NGW = n_cus * NWAVES;
    for (int n = gw; n < N; n += NGW) {
        float w[4][8];
#pragma unroll
        for (int j = 0; j < 4; ++j) { const v4u wv = *(const GAS v4u*)(WT + (size_t)n * DM + 512 * j + 8 * F.lane);
            w[j][0] = bf_lo(wv.x); w[j][1] = bf_hi(wv.x); w[j][2] = bf_lo(wv.y); w[j][3] = bf_hi(wv.y); w[j][4] = bf_lo(wv.z); w[j][5] = bf_hi(wv.z); w[j][6] = bf_lo(wv.w); w[j][7] = bf_hi(wv.w); }
        float d[5];
#pragma unroll
        for (int r = 0; r < 5; ++r) { d[r] = 0.f;
#pragma unroll
            for (int j = 0; j < 4; ++j) { const f32x4v s0 = *(const LAS f32x4v*)(SH + r * DM + 512 * j + 8 * F.lane), s1 = *(const LAS f32x4v*)(SH + r * DM + 512 * j + 8 * F.lane + 4);
                d[r] += (w[j][0] * s0.x + w[j][1] * s0.y) + (w[j][2] * s0.z + w[j][3] * s0.w) + (w[j][4] * s1.x + w[j][5] * s1.y) + (w[j][6] * s1.z + w[j][7] * s1.w); } }
#pragma unroll
        for (int r = 0; r < 5; ++r) d[r] = wave_sum(d[r]);
        if (F.lane == 0) {
#pragma unroll
            for (int r = 0; r < 5; ++r) shw[(size_t)r * N + n] = d[r]; }
    }
}
__device__ __forceinline__ void final_norm_phase(Frame& F, const bf16* X, const float* g, float* out) {
    const int gw = F.vcu * NWAVES + F.wave, NGW = F.G * NWAVES;
    f32x4v gg[8];
#pragma unroll
    for (int j = 0; j < 8; ++j) gg[j] = *(const f32x4v*)(g + 256 * j + 4 * F.lane);
    for (int row = gw; row < MLAT; row += 2 * NGW) {
        const int row1 = row + NGW; const bool has1 = row1 < MLAT;
        const bf16* xr0 = X + (size_t)row * DM; const bf16* xr1 = X + (size_t)(has1 ? row1 : row) * DM;
        u32x2 r0[8], r1[8];
#pragma unroll
        for (int j = 0; j < 8; ++j) r0[j] = *(const u32x2*)(xr0 + 256 * j + 4 * F.lane);
#pragma unroll
        for (int j = 0; j < 8; ++j) r1[j] = *(const u32x2*)(xr1 + 256 * j + 4 * F.lane);
        f32x4v v0[8], v1[8]; float s0 = 0.f, s1 = 0.f;
#pragma unroll
        for (int j = 0; j < 8; ++j) { v0[j] = (f32x4v){bf_lo(r0[j].x), bf_hi(r0[j].x), bf_lo(r0[j].y), bf_hi(r0[j].y)};
            s0 += (v0[j].x * v0[j].x + v0[j].y * v0[j].y) + (v0[j].z * v0[j].z + v0[j].w * v0[j].w); }
#pragma unroll
        for (int j = 0; j < 8; ++j) { v1[j] = (f32x4v){bf_lo(r1[j].x), bf_hi(r1[j].x), bf_lo(r1[j].y), bf_hi(r1[j].y)};
            s1 += (v1[j].x * v1[j].x + v1[j].y * v1[j].y) + (v1[j].z * v1[j].z + v1[j].w * v1[j].w); }
        const float rstd0 = rsqrtf(wave_sum(s0) * (1.0f / DM) + EPS), rstd1 = rsqrtf(wave_sum(s1) * (1.0f / DM) + EPS);
#pragma unroll
        for (int j = 0; j < 8; ++j) *(f32x4v*)(out + (size_t)row * DM + 256 * j + 4 * F.lane) = (v0[j] * rstd0) * gg[j];
        if (has1) {
#pragma unroll
            for (int j = 0; j < 8; ++j) *(f32x4v*)(out + (size_t)row1 * DM + 256 * j + 4 * F.lane) = (v1[j] * rstd1) * gg[j]; }
    }
}

namespace mix {
constexpr int KSTR = 272, VSTR = 288;
constexpr int KBUF = 64 * KSTR, VBUF = 64 * VSTR, CHB = KBUF + VBUF;
constexpr int BIAS_OFF = 2 * CHB;
constexpr int CW_OFF = BIAS_OFF + NH * RPB_HS * 4, GCV_OFF = CW_OFF + 3 * CVW * 4;
constexpr int MIX_LDS = GCV_OFF + CVW * 4;
static_assert(CW_OFF % 16 == 0, "LDS alignment");
typedef float f32x2_t __attribute__((ext_vector_type(2))); typedef __bf16 bf16x2_t __attribute__((ext_vector_type(2)));
__device__ __forceinline__ unsigned cvtpk(float lo, float hi) { f32x2_t v = {lo, hi}; bf16x2_t b = __builtin_convertvector(v, bf16x2_t); return __builtin_bit_cast(unsigned, b); }
static_assert(MIX_LDS <= RING_BYTES, "mixer LDS");
constexpr float LOG2E = 1.4426950408889634f;
constexpr float SC2 = 0.08838834764831845f * LOG2E;
constexpr float NEG = -1.0e30f;

struct ChunkRegs { v4u k0, k1, v0, v1; };
__device__ __forceinline__ void chunk_load(ChunkRegs& R, const bf16* P, int tid, int h, int ci, int nloc, int a_lo, int lat0, int ctx0) {
    const int krow0 = ci < nloc ? lat0 + (a_lo + ci) * GRID_W : ctx0 + (ci - nloc) * 64;
    const int key = tid >> 4, c16 = tid & 15;
    const bf16* p0 = P + (size_t)(krow0 + key) * PPITCH + h * HD + 8 * c16;
    const bf16* p1 = p0 + (size_t)32 * PPITCH;
    R.k0 = *(const GAS v4u*)(p0 + COL_K); R.k1 = *(const GAS v4u*)(p1 + COL_K);
    R.v0 = *(const GAS v4u*)(p0 + COL_V); R.v1 = *(const GAS v4u*)(p1 + COL_V);
}
__device__ __forceinline__ void chunk_store(const ChunkRegs& R, LAS unsigned char* buf, int tid) {
    const int key = tid >> 4, c16 = tid & 15;
    *(LAS v4u*)(buf + key * KSTR + 16 * c16) = R.k0; *(LAS v4u*)(buf + (key + 32) * KSTR + 16 * c16) = R.k1;
    *(LAS v4u*)(buf + KBUF + key * VSTR + 16 * c16) = R.v0; *(LAS v4u*)(buf + KBUF + (key + 32) * VSTR + 16 * c16) = R.v1;
}

template <unsigned NEED, bool LOC, class LD>
__device__ __forceinline__ void chunk_compute(const LAS unsigned char* Kb, const LAS unsigned char* Vb, bf16x8 (&qf)[4], f32x4v (&O)[8], float& m_run, float& l_run,
                                              const LAS float* bt, int qi, int g, int d0, int v0, const bf16* qnext, const LD& issue_prefetch) {
    f32x4v sa[4];
#pragma unroll
    for (int kt = 0; kt < 4; ++kt) sa[kt] = (f32x4v){0.f, 0.f, 0.f, 0.f};
    const LAS unsigned char* kp = Kb + qi * KSTR + 16 * g;
    bf16x8 kfr[2][4];
#define MIX_KREAD(set, ks_) do { _Pragma("unroll") for (int kt = 0; kt < 4; ++kt) if ((NEED >> kt) & 1u) kfr[set][kt] = *(const LAS bf16x8*)(kp + 16 * kt * KSTR + 64 * (ks_)); } while (0)
    MIX_KREAD(0, 0);
#pragma unroll
    for (int ks = 0; ks < 4; ++ks) {
        if (ks + 1 < 4) { if (((ks + 1) & 1) == 0) MIX_KREAD(0, ks + 1); else MIX_KREAD(1, ks + 1); }
        __builtin_amdgcn_sched_barrier(0);
#pragma unroll
        for (int kt = 0; kt < 4; ++kt)
            if ((NEED >> kt) & 1u) sa[kt] = __builtin_amdgcn_mfma_f32_16x16x32_bf16(kfr[ks & 1][kt], qf[ks], sa[kt], 0, 0, 0);
        __builtin_amdgcn_sched_barrier(0);
    }
#undef MIX_KREAD
    constexpr bool NP0 = (NEED & 3u) != 0u, NP1 = (NEED & 0xCu) != 0u; constexpr int NG = 2 * ((NP0 ? 1 : 0) + (NP1 ? 1 : 0));
#define MIX_PPOF(gi) (NP0 ? ((gi) >> 1) : 1)
    const LAS unsigned char* vbase = Vb + (4 * g + (qi >> 2)) * VSTR + 8 * (qi & 3);
    v4i16_t va[2][8];
#define MIX_VREAD(set, gi) do { _Pragma("unroll") for (int d4 = 0; d4 < 4; ++d4) { const int dt_ = 4 * ((gi) & 1) + d4; \
        va[set][d4] = __builtin_amdgcn_ds_read_tr16_b64_v4i16((LAS v4i16_t*)(vbase + 32 * MIX_PPOF(gi) * VSTR + 32 * dt_)); \
        va[set][4 + d4] = __builtin_amdgcn_ds_read_tr16_b64_v4i16((LAS v4i16_t*)(vbase + (32 * MIX_PPOF(gi) + 16) * VSTR + 32 * dt_)); } } while (0)
    MIX_VREAD(0, 0);
    issue_prefetch();
    if (!LOC) {
#pragma unroll
        for (int ks = 0; ks < 4; ++ks) qf[ks] = *(const GAS bf16x8*)(qnext + 32 * ks); }
    float s[4][4];
    if (LOC) {
        float bv[4][4];
#pragma unroll
        for (int kt = 0; kt < 4; ++kt)
            if ((NEED >> kt) & 1u) {
#pragma unroll
                for (int e = 0; e < 4; ++e) { const int dcol = d0 + 16 * kt + e; bv[kt][e] = bt[min(max(dcol, 0), RPB_C - 1)]; asm volatile("" : "+v"(bv[kt][e])); } }
#pragma unroll
        for (int kt = 0; kt < 4; ++kt)
#pragma unroll
            for (int e = 0; e < 4; ++e) {
                if ((NEED >> kt) & 1u) { const bool valid = (unsigned)(v0 + 16 * kt + e) < (unsigned)WIN_C; s[kt][e] = valid ? sa[kt][e] * SC2 + bv[kt][e] : NEG; }
                else s[kt][e] = NEG; }
    } else {
#pragma unroll
        for (int kt = 0; kt < 4; ++kt)
#pragma unroll
            for (int e = 0; e < 4; ++e) s[kt][e] = ((NEED >> kt) & 1u) ? sa[kt][e] * SC2 : NEG;
    }
    float mx = NEG;
#pragma unroll
    for (int kt = 0; kt < 4; ++kt)
        if ((NEED >> kt) & 1u) {
#pragma unroll
            for (int e = 0; e < 4; ++e) mx = fmaxf(mx, s[kt][e]); }
    mx = x32_max(x16_max(mx));
    const float m_new = fmaxf(m_run, mx);
    {
        const float alpha = __builtin_amdgcn_exp2f(m_run - m_new);
        l_run *= alpha;
#pragma unroll
        for (int dt = 0; dt < 8; ++dt) O[dt] = O[dt] * alpha;
    }
    m_run = m_new;
    float psum = 0.f; unsigned pk[4][2];
#pragma unroll
    for (int kt = 0; kt < 4; ++kt) {
        if ((NEED >> kt) & 1u) { float p[4];
#pragma unroll
            for (int e = 0; e < 4; ++e) { p[e] = __builtin_amdgcn_exp2f(s[kt][e] - m_new); psum += p[e]; }
            pk[kt][0] = cvtpk(p[0], p[1]); pk[kt][1] = cvtpk(p[2], p[3]); }
        else { pk[kt][0] = 0u; pk[kt][1] = 0u; } }
    l_run += psum;
    bf16x8 pf[2];
#pragma unroll
    for (int pp = 0; pp < 2; ++pp) { const v4u pw = (v4u){pk[2 * pp][0], pk[2 * pp][1], pk[2 * pp + 1][0], pk[2 * pp + 1][1]}; pf[pp] = __builtin_bit_cast(bf16x8, pw); }
#pragma unroll
    for (int gi = 0; gi < NG; ++gi) {
        if (gi + 1 < NG) { if (((gi + 1) & 1) == 0) MIX_VREAD(0, gi + 1); else MIX_VREAD(1, gi + 1); }
#pragma unroll
        for (int d4 = 0; d4 < 4; ++d4) { const int dt = 4 * (gi & 1) + d4; const v4i16_t lo = va[gi & 1][d4], hi = va[gi & 1][4 + d4];
            const bf16x8 vf = (bf16x8){lo[0], lo[1], lo[2], lo[3], hi[0], hi[1], hi[2], hi[3]};
            O[dt] = __builtin_amdgcn_mfma_f32_16x16x32_bf16(vf, pf[MIX_PPOF(gi)], O[dt], 0, 0, 0); }
    }
#undef MIX_VREAD
#undef MIX_PPOF
}

__device__ __forceinline__ void mixer_unit(Frame& F, int u, const bf16* P, bf16* MIXO, const float* conv_w, const float* g_na, const float* g_cv, float* ssqh, bool bal, float* rna) {
    LAS unsigned char* L = F.lds + RING_OFF;
    const LAS float* btab = (const LAS float*)(L + BIAS_OFF);
    const int w = F.wave;
    const bool lat = u < 256;
    int b, tok0, nloc, a_lo, r0, seq_lo, seq_hi;
    if (lat) { b = u >> 6; r0 = 2 * (u & 63); tok0 = b * SEQ + r0 * GRID_W; a_lo = min(max(r0 - 4, 0), GRID_R - WIN_R); const int a_hi = min(max(r0 + 1 - 4, 0), GRID_R - WIN_R) + WIN_R - 1; nloc = a_hi - a_lo + 1;
               seq_lo = b * SEQ; seq_hi = seq_lo + SEQ; }
    else { const int v = u - 256; b = v >> 4; r0 = 0; tok0 = MLAT + b * CTXL + 128 * ((v >> 3) & 1); a_lo = 0; nloc = 0; seq_lo = MLAT + b * CTXL; seq_hi = seq_lo + CTXL; }
    const int h_lo = lat ? 0 : ((u - 256) & 7), h_hi = lat ? NH : h_lo + 1;
    const int lat0 = b * SEQ, ctx0 = MLAT + b * CTXL;
    const int nch = nloc + 4;
    const int rw = r0 + (w >> 2), qt = (w & 3) ^ (w >> 2);
    const int tw = 64 * (w >> 2) + 16 * qt;
    const int rs_w = min(max(rw - 4, 0), GRID_R - WIN_R);
    const int kb0 = qt == 0 ? 0 : qt == 1 ? 8 : qt == 2 ? 24 : 32;

    const bool conv_first = (F.vcu & 1) != 0;
#pragma unroll 1
    for (int pass = 0; pass < 2; ++pass) {
    if ((pass == 0) != conv_first) {
    int tid_a = threadIdx.x; asm volatile("" : "+v"(tid_a));
    const int tid = tid_a, lane_a = tid_a & 63, qi = lane_a & 15, g = lane_a >> 4;
    const int cq = 16 * qt + qi;
    const int cs = min(max(cq - 8, 0), GRID_W - WIN_C);
    const int d0 = 4 * g - cq + (WIN_C - 1), v0 = 4 * g - cs;
    const int qrow = tok0 + tw + qi;
    ChunkRegs CR;
    bf16x8 qf[4];
#pragma unroll
    for (int ks = 0; ks < 4; ++ks) qf[ks] = *(const GAS bf16x8*)(P + (size_t)qrow * PPITCH + COL_Q + h_lo * HD + 32 * ks + 8 * g);
    const int total = (h_hi - h_lo) * nch;
    chunk_load(CR, P, tid, h_lo, 0, nloc, a_lo, lat0, ctx0);
    chunk_store(CR, L, tid);
    __syncthreads();

    float ssq = 0.f;
    f32x4v O[8]; float m_run = NEG, l_run = 0.f;
#pragma unroll
    for (int dt = 0; dt < 8; ++dt) O[dt] = (f32x4v){0.f, 0.f, 0.f, 0.f};
    int h = h_lo, ci = 0;
    int h2 = h_lo, c2 = 1;
#define MIX_STEP(BUF, S_) do { \
        const bool lastc = ci == nch - 1; \
        auto pre = [&]() { chunk_load(CR, P, tid, min(h2, h_hi - 1), c2, nloc, a_lo, lat0, ctx0); };     \
        const LAS unsigned char* Kb = L + (BUF) * CHB; const LAS unsigned char* Vb = Kb + KBUF; \
        if (ci < nloc) { const int a = a_lo + ci; \
            if (a >= rs_w && a < rs_w + WIN_R) { const LAS float* bt = btab + h * RPB_HS + (a - rw + WIN_R - 1) * RPB_C; \
                chunk_compute<0x3u, true>(Kb + kb0 * KSTR, Vb + kb0 * VSTR, qf, O, m_run, l_run, bt, qi, g, d0 + kb0, v0 + kb0, (const bf16*)nullptr, pre); }     \
            else pre(); \
        } else chunk_compute<0xFu, false>(Kb, Vb, qf, O, m_run, l_run, btab, qi, g, d0, v0, P + (size_t)qrow * PPITCH + COL_Q + ((lastc && h < h_hi - 1) ? h + 1 : h) * HD + 8 * g, pre); \
        chunk_store(CR, L + (1 - (BUF)) * CHB, tid);     \
        if (lastc) { float lt = x32_sum(x16_sum(l_run)); const float inv = 1.0f / lt; \
            bf16* op = MIXO + (size_t)qrow * DM + h * HD + 4 * g; \
            _Pragma("unroll") for (int dt = 0; dt < 8; ++dt) { f32x4v o = O[dt] * inv; ssq += (o.x * o.x + o.y * o.y) + (o.z * o.z + o.w * o.w); \
                u32x2 ov; ov.x = cvtpk(o.x, o.y); ov.y = cvtpk(o.z, o.w); *(GAS u32x2*)(op + 16 * dt) = ov; O[dt] = (f32x4v){0.f, 0.f, 0.f, 0.f}; } \
            m_run = NEG; l_run = 0.f; } \
        LDS_WAIT(); __builtin_amdgcn_s_barrier(); asm volatile("" ::: "memory"); __builtin_amdgcn_s_barrier(); asm volatile("" ::: "memory"); __builtin_amdgcn_s_barrier(); asm volatile("" ::: "memory");     \
        if (++ci == nch) { ci = 0; ++h; } if (++c2 == nch) { c2 = 0; ++h2; } \
    } while (0)
    for (int s = 0; s < total; s += 2) { MIX_STEP(0, s); MIX_STEP(1, s + 1); }
#undef MIX_STEP
    ssq = x32_sum(x16_sum(ssq));
    const float rstd = rsqrtf(ssq * (1.0f / NAW) + EPS);
    if (!lat && g == 0) ssqh[(size_t)(qrow - MLAT) * NH + h_lo] = ssq;
    if (lat && (lane_a >> 4) == 0) rna[tok0 + tw + qi] = rstd;
    } else {
    {
        int lane_c = F.lane; asm volatile("" : "+v"(lane_c)); const int lane = lane_c;
        const LAS float* cwl = (const LAS float*)(L + CW_OFF) + 8 * lane; const LAS float* gcl = (const LAS float*)(L + GCV_OFF) + 8 * lane;
        struct CvSet { v4u c[2], b[2]; };
        float cu[3][2][8];
#define CV_PROD(dst, A_) do { _Pragma("unroll") for (int j = 0; j < 2; ++j) { const v4u a_ = (A_)[j]; \
            dst[j][0] = bf_lo(a_.x); dst[j][1] = bf_hi(a_.x); dst[j][2] = bf_lo(a_.y); dst[j][3] = bf_hi(a_.y); \
            dst[j][4] = bf_lo(a_.z); dst[j][5] = bf_hi(a_.z); dst[j][6] = bf_lo(a_.w); dst[j][7] = bf_hi(a_.w); } } while (0)
#define CV_LOADROW(CC, row) do { const bool ok_ = (row) >= seq_lo && (row) < seq_hi; _Pragma("unroll") for (int j = 0; j < 2; ++j) { (CC)[j] = (v4u){0u, 0u, 0u, 0u}; \
            if (ok_) (CC)[j] = *(const GAS v4u*)(P + (size_t)(row) * PPITCH + COL_CG + 8 * lane + 512 * j); } } while (0)
#define CV_ISSUE(S, tt) do { CV_LOADROW((S).c, (tt) + 1); _Pragma("unroll") for (int j = 0; j < 2; ++j) (S).b[j] = *(const GAS v4u*)(P + (size_t)(tt) * PPITCH + COL_BG + 8 * lane + 512 * j); } while (0)
#define CV_TOKEN(S, tt, more) do { \
            CV_PROD(cu[2], (S).c); const v4u bg0_ = (S).b[0], bg1_ = (S).b[1]; \
            if (more) CV_ISSUE(S, (tt) + 1); \
            float o[2][8]; float ss = 0.f; \
            _Pragma("unroll") for (int j = 0; j < 2; ++j) { const v4u bgv = j ? bg1_ : bg0_; \
                const float bgf[8] = {bf_lo(bgv.x), bf_hi(bgv.x), bf_lo(bgv.y), bf_hi(bgv.y), bf_lo(bgv.z), bf_hi(bgv.z), bf_lo(bgv.w), bf_hi(bgv.w)}; \
                _Pragma("unroll") for (int e4 = 0; e4 < 2; ++e4) { const f32x4v w0 = *(const LAS f32x4v*)(cwl + 512 * j + 4 * e4), w1 = *(const LAS f32x4v*)(cwl + CVW + 512 * j + 4 * e4), w2 = *(const LAS f32x4v*)(cwl + 2 * CVW + 512 * j + 4 * e4); \
                    _Pragma("unroll") for (int e = 0; e < 4; ++e) { const int ee = 4 * e4 + e; const float cvv = w0[e] * cu[0][j][ee] + w1[e] * cu[1][j][ee] + w2[e] * cu[2][j][ee]; o[j][ee] = bgf[ee] * cvv; ss += o[j][ee] * o[j][ee]; } } } \
            const float rs = rsqrtf(wave_sum(ss) * (1.0f / CVW) + EPS); \
            _Pragma("unroll") for (int j = 0; j < 2; ++j) { const f32x4v g0 = *(const LAS f32x4v*)(gcl + 512 * j), g1 = *(const LAS f32x4v*)(gcl + 512 * j + 4); v4u ov; \
                ov.x = cvtpk(o[j][0] * rs * g0.x, o[j][1] * rs * g0.y); ov.y = cvtpk(o[j][2] * rs * g0.z, o[j][3] * rs * g0.w); \
                ov.z = cvtpk(o[j][4] * rs * g1.x, o[j][5] * rs * g1.y); ov.w = cvtpk(o[j][6] * rs * g1.z, o[j][7] * rs * g1.w); \
                *(GAS v4u*)(MIXO + (size_t)(tt) * DM + NAW + 8 * lane + 512 * j) = ov; } \
            _Pragma("unroll") for (int j = 0; j < 2; ++j) _Pragma("unroll") for (int e = 0; e < 8; ++e) { cu[0][j][e] = cu[1][j][e]; cu[1][j][e] = cu[2][j][e]; } \
        } while (0)
        CvSet SA;
        const int gm = u & 3;
        const int nseg = (lat && bal && gm != 3) ? 2 : 1;
#pragma unroll 1
        for (int seg = 0; seg < nseg; ++seg) {
        const int ntok = !lat ? 2 : (seg == 1 ? 2 : ((bal && gm == 3) ? 10 : 16));
        const int tc0 = !lat ? tok0 + 16 * h_lo + 2 * w : (seg == 1 ? tok0 + (3 - gm) * 128 + 80 + 16 * gm + 2 * w : ((bal && gm == 3) ? tok0 + 10 * w : tok0 + 16 * w));
        { v4u c_[2]; CV_LOADROW(c_, tc0 - 1); CV_PROD(cu[0], c_); CV_LOADROW(c_, tc0); CV_PROD(cu[1], c_); }
        CV_ISSUE(SA, tc0);
#pragma unroll 1
        for (int t = 0; t < ntok; ++t) CV_TOKEN(SA, tc0 + t, t + 1 < ntok);
        }
#undef CV_PROD
#undef CV_LOADROW
#undef CV_ISSUE
#undef CV_TOKEN
    }
    }
    }
}
__device__ __forceinline__ void mixer_phase(Frame& F, const bf16* P, bf16* MIXO, const float* rpb_l, const float* conv_w, const float* g_na, const float* g_cv, int n_units, float* ssqh, float* rna) {
    LAS float* btab = (LAS float*)(F.lds + RING_OFF + BIAS_OFF);
    for (int i = F.tid; i < NH * RPB_HS; i += NWAVES * 64) btab[i] = rpb_l[i] * LOG2E;
    { LAS float* cwl = (LAS float*)(F.lds + RING_OFF + CW_OFF); for (int i = F.tid; i < 3 * CVW; i += NWAVES * 64) cwl[i] = conv_w[i];
      LAS float* gcl = (LAS float*)(F.lds + RING_OFF + GCV_OFF); for (int i = F.tid; i < CVW; i += NWAVES * 64) gcl[i] = g_cv[i]; }
    __syncthreads();
    const bool bal = n_units > 256 && F.G == 256;
    for (int u = F.vcu; u < n_units && u < 256; u += F.G) mixer_unit(F, u, P, MIXO, conv_w, g_na, g_cv, ssqh, bal, rna);
    if (n_units > 256 && F.G == 256) { if ((F.vcu & 3) == 3) mixer_unit(F, 256 + (F.vcu >> 2), P, MIXO, conv_w, g_na, g_cv, ssqh, false, rna); }
    else for (int u = 256 + F.vcu; u < n_units; u += F.G) mixer_unit(F, u, P, MIXO, conv_w, g_na, g_cv, ssqh, false, rna);
    __syncthreads();
}
}

struct Args { const float* in[17]; float* out; unsigned char* ws; int ph_lo, ph_hi; };
__global__ void __launch_bounds__(NWAVES * 64, 2) skel_fwd(Args args) {
    extern __shared__ __attribute__((aligned(16))) unsigned char lds[];
    Frame F;
    F.lds = (LAS unsigned char*)lds;
    F.MISC = (volatile LAS unsigned*)(F.lds + MISC_OFF);
    F.tid = threadIdx.x; F.lane = F.tid & 63; F.wave = __builtin_amdgcn_readfirstlane(F.tid >> 6);
    F.G = gridDim.x; { const int bx = blockIdx.x; F.vcu = (F.G % 8 == 0) ? (bx % 8) * (F.G / 8) + bx / 8 : bx; }
    unsigned char* ws = args.ws;
    F.ctl = (gu32*)(ws + WS_CTL);
    const float *in_x = args.in[0], *in_ctx = args.in[2];
#define MOD ((float*)(ws + WS_MOD))
#define VEC ((const float*)(ws + WS_VEC))
#define WIN_T ((bf16*)(ws + WS_WIN))
#define WOUT_T ((bf16*)(ws + WS_WOUT))
#define W1_T ((bf16*)(ws + WS_W1))
#define W2_T ((bf16*)(ws + WS_W2))
#define X ((bf16*)(ws + WS_X))
#define XN ((bf16*)(ws + WS_XN))
#define PB ((bf16*)(ws + WS_P))
#define MIXB ((bf16*)(ws + WS_MIX))
#define HB ((bf16*)(ws + WS_H))
#define PO ((float*)(ws + WS_PO))
#define PM ((float*)(ws + WS_PM))
#define SSQ ((float*)(ws + WS_SSQ))
#define SHW ((float*)(ws + WS_SHW))
#define SSQP ((float*)(ws + WS_SSQP))
    for (int u = F.tid; u < (LDS_BYTES - LDSCTL_OFF) / 4; u += NWAVES * 64) ((LAS unsigned*)(F.lds + LDSCTL_OFF))[u] = 0u;
    __syncthreads();
#if MK_PER_PHASE
#define GRID_BAR() do { } while (0)
#else
    XcdBarrier bar = xcd_barrier_post((unsigned*)(F.ctl + CW_BAR), F.MISC + 8);
#define GRID_BAR() xcd_barrier(bar)
#endif
    const int lo = args.ph_lo, hi = args.ph_hi;
#define IN(k) (lo <= (k) && (k) < hi)
#define SEAM(k) do { if (IN((k) + 1)) GRID_BAR(); } while (0)

    if (IN(0)) {
        ProIn I{args.in[1], args.in[3], args.in[4], args.in[5], args.in[7], args.in[12], args.in[14], args.in[15], args.in[6], args.in[13], args.in[8], args.in[9], args.in[10], args.in[11], args.in[16], MOD, (float*)(ws + WS_VEC), WIN_T, WOUT_T, W1_T, W2_T};
        p0_prologue(F, I);
        SEAM(0);
    }
    for (int l = 0; l < DEPTH; ++l) {
        const int pb = 1 + 7 * l;
        const bool last = l == DEPTH - 1;
        const int Mg = last ? MLAT : MT;
        const float* mod_l = MOD + (size_t)l * 5 * MODW;
        const float* vec_l = VEC + (size_t)l * VEC_L;
        bf16* const Xc = X + (size_t)MLAT * DM;
        float* ssq1 = SSQ + (size_t)(2 * l) * MT; float* ssq2 = SSQ + (size_t)(2 * l + 1) * MT;
        float* shw1 = SHW + (size_t)l * 5 * INC; float* shw2 = SHW + (size_t)DEPTH * 5 * INC + (size_t)l * 5 * DFF;
#define OPAQUE_TID() do { int t_ = threadIdx.x; asm volatile("" : "+v"(t_)); F.tid = t_; F.lane = t_ & 63; F.wave = __builtin_amdgcn_readfirstlane(t_ >> 6); } while (0)
        if (IN(pb + 0)) { OPAQUE_TID();
            if (l == 0) norm_prep0_phase(F, in_x, in_ctx, vec_l + VEC_G1, mod_l + 1 * DM, XN, ssq1);
            else { ctx_norm_phase(F, (const float*)nullptr, Xc, vec_l + VEC_G1, mod_l + 1 * DM, XN, ssq1, PM, mod_l - 5 * MODW + 4 * MODW + 5 * DM, Xc, (const float*)nullptr);
                   ssq_reduce_phase(F, SSQP, ssq1, MLAT); }
            if (l == 0) { shw_phase(F, WIN_T, MOD + 0 * DM, SHW, INC, F.vcu, F.G);
                          shw_phase(F, W1_T, MOD + 3 * DM, SHW + (size_t)DEPTH * 5 * INC, DFF, F.vcu, F.G); }
            SEAM(pb + 0); }
        if (IN(pb + 1)) { OPAQUE_TID();
            pg8::Gemm g{XN, WIN_T + (size_t)l * INC * DM, MT, INC, DM}; pg8::CtxColsOrder S;
            S.init(MLAT, INC, F.G, (int)blockIdx.x, DM, MLAT / 256, last ? COL_K / 256 : 0, last ? (COL_BG - COL_K) / 256 : INC / 256);
            pg8::EpiBf16<0, true> E{PB, PPITCH, ssq1, shw1, INC, COL_CG / 256, COL_CG};
            pg8::gemm_phase<pg8::EpiBf16<0, true>, pg8::CtxColsOrder, true, true>(F.lds + RING_OFF, g, S, E, F.tid);
            if (!last) {
                const int nwg_ = (MT / 256) * (INC / 256), rounds_ = (nwg_ + F.G - 1) / F.G, first_idle = nwg_ - (rounds_ - 1) * F.G, c_ = (int)blockIdx.x;
                const bool all_ = first_idle >= F.G;
                if (all_ || c_ >= first_idle) { OPAQUE_TID();
                    const int rank_ = all_ ? F.vcu : c_ - first_idle, ncu_ = all_ ? F.G : F.G - first_idle;
                    shw_phase(F, WIN_T + (size_t)(l + 1) * INC * DM, MOD + (size_t)(l + 1) * 5 * MODW + 0 * DM, SHW + (size_t)(l + 1) * 5 * INC, INC, rank_, ncu_);
                    shw_phase(F, W1_T + (size_t)(l + 1) * DFF * DM, MOD + (size_t)(l + 1) * 5 * MODW + 3 * DM, SHW + (size_t)DEPTH * 5 * INC + (size_t)(l + 1) * 5 * DFF, DFF, rank_, ncu_); } }
            SEAM(pb + 1);
        }
        if (IN(pb + 2)) { OPAQUE_TID();
            mix::mixer_phase(F, PB, MIXB, vec_l + VEC_RPB, vec_l + VEC_CW, vec_l + VEC_GNA, vec_l + VEC_GCV, last ? 256 : 320, (float*)(ws + WS_VEC + 512 * 1024), (float*)(ws + WS_SSQ + 1536 * 1024));
            SEAM(pb + 2);
        }
        if (IN(pb + 3)) { OPAQUE_TID();
            pg8::Gemm g{MIXB, WOUT_T + (size_t)l * DM * DM, Mg, DM, DM}; pg8::CtxSplitOrder S; S.init(MLAT, DM, F.G, (int)blockIdx.x, DM, last ? 0 : NSPLIT, MLAT / 256);
            pg8::EpiGateResSplitMid E{{{l == 0 ? in_x : (const float*)nullptr, X, X, mod_l + 2 * DM, DM, MODW, XN, SSQP, MT, vec_l + VEC_G2, mod_l + 4 * DM}, PO, MLAT / 256, DM}, (const float*)(ws + WS_SSQ + 1536 * 1024)};
            pg8::gemm_phase<pg8::EpiGateResSplitMid, pg8::CtxSplitOrder, true, true>(F.lds + RING_OFF, g, S, E, F.tid);
            SEAM(pb + 3);
        }
        if (IN(pb + 4)) { OPAQUE_TID();
            if (!last) ctx_norm_phase(F, l == 0 ? in_ctx : (const float*)nullptr, Xc, vec_l + VEC_G2, mod_l + 4 * DM, XN, ssq2, PO, mod_l + 4 * MODW + 2 * DM, Xc, (const float*)(ws + WS_VEC + 512 * 1024));
            ssq_reduce_phase(F, SSQP, ssq2, MLAT);
            SEAM(pb + 4); }
        if (IN(pb + 5)) { OPAQUE_TID();
            pg8::Gemm g{XN, W1_T + (size_t)l * DFF * DM, Mg, DFF, DM}; pg8::StaticOrder S; S.init(Mg, DFF, F.G, (int)blockIdx.x, DM);
            pg8::EpiBf16<2> E{HB, DFF, ssq2, shw2, DFF};
            pg8::gemm_phase<pg8::EpiBf16<2>, pg8::StaticOrder, true, true>(F.lds + RING_OFF, g, S, E, F.tid);
            SEAM(pb + 5);
        }
        if (IN(pb + 6)) { OPAQUE_TID();
            pg8::Gemm g{HB, W2_T + (size_t)l * DM * DFF, Mg, DM, DFF}; pg8::CtxSplitOrder S; S.init(MLAT, DM, F.G, (int)blockIdx.x, DFF, last ? 0 : NSPLIT, MLAT / 256);
            pg8::EpiGateResSplit E{{(const float*)nullptr, X, X, mod_l + 5 * DM, DM, MODW, last ? (bf16*)nullptr : XN, SSQP, MT, vec_l + VEC_L + VEC_G1, mod_l + 5 * MODW + 1 * DM}, PM, MLAT / 256, DM};
            pg8::gemm_phase<pg8::EpiGateResSplit, pg8::CtxSplitOrder, true, true>(F.lds + RING_OFF, g, S, E, F.tid);
            SEAM(pb + 6);
        }
    }
    if (IN(N_PHASES - 1)) final_norm_phase(F, X, VEC + VEC_GF, args.out);
#undef IN
#undef SEAM
}

extern "C" void kernel_launch(void* const* d_in, const int* in_sizes, int n_in, void* d_out, int out_size, void* d_ws, size_t ws_size, hipStream_t stream) {
    static int grid = 0;
    if (grid == 0) {
        if (n_in != 17 || in_sizes[0] != MLAT * DM || out_size != MLAT * DM || ws_size < WS_END) { fprintf(stderr, "kernel_launch: shape/workspace mismatch: n_in %d, in0 %d, out %d, ws %zu (need %zu); nothing launched\n", n_in, n_in > 0 ? in_sizes[0] : -1, out_size, ws_size, (size_t)WS_END); grid = -1; return; }
        int dev = 0, cus = 0, per_cu = 0;
        if (hipGetDevice(&dev) != hipSuccess || hipDeviceGetAttribute(&cus, hipDeviceAttributeMultiprocessorCount, dev) != hipSuccess) { fprintf(stderr, "kernel_launch: hipGetDevice / hipDeviceGetAttribute failed; nothing launched\n"); grid = -1; return; }
        if (hipFuncSetAttribute((const void*)skel_fwd, hipFuncAttributeMaxDynamicSharedMemorySize, LDS_BYTES) != hipSuccess) { fprintf(stderr, "kernel_launch: hipFuncSetAttribute failed; nothing launched\n"); grid = -1; return; }
        if (hipOccupancyMaxActiveBlocksPerMultiprocessor(&per_cu, (const void*)skel_fwd, NWAVES * 64, LDS_BYTES) != hipSuccess || per_cu < 1)
            fprintf(stderr, "kernel_launch: note: the occupancy query reports %d workgroups per CU\n", per_cu);
        (void)hipGetLastError();
        grid = cus;
    }
    if (grid < 0) return;
    if (hipMemsetAsync((char*)d_ws + WS_CTL, 0, CTL_ZERO_BYTES, stream) != hipSuccess) { fprintf(stderr, "kernel_launch: hipMemsetAsync of the control words failed; nothing launched\n"); return; }
    Args a{};
    for (int i = 0; i < 17; ++i) a.in[i] = (const float*)d_in[i];
    a.out = (float*)d_out; a.ws = (unsigned char*)d_ws;
#if MK_PER_PHASE
    for (int p = 0; p < N_PHASES; ++p) { a.ph_lo = p; a.ph_hi = p + 1; hipLaunchKernelGGL(skel_fwd, dim3(grid), dim3(NWAVES * 64), LDS_BYTES, stream, a); }
#else
    a.ph_lo = 0; a.ph_hi = N_PHASES;
    hipLaunchKernelGGL(skel_fwd, dim3(grid), dim3(NWAVES * 64), LDS_BYTES, stream, a);
#endif
    const hipError_t le = hipPeekAtLastError();
    if (le != hipSuccess) fprintf(stderr, "kernel_launch: launch failed: %s (grid %d x %d threads, %d B LDS)\n", hipGetErrorName(le), grid, NWAVES * 64, LDS_BYTES);
}
```

```cpp
#include <hip/hip_runtime.h>
#include <cstdio>
#include <cstdint>
namespace pg8 {
#define PG8_LAS __attribute__((address_space(3)))
typedef unsigned short bf16_t;
typedef short bf16x8 __attribute__((ext_vector_type(8)));
typedef float f32x4 __attribute__((ext_vector_type(4)));
typedef unsigned u32x4 __attribute__((ext_vector_type(4)));
constexpr int BM = 256, BK = 64, HALF = 128, HTB = HALF * BK * 2  , STAGE_BYTES = 8 * HTB, NXCD = 8;

__host__ __device__ __forceinline__ int lds_byte(int r, int c) { const int st = (r >> 4) * 2 + (c >> 5), rr = r & 15, cc = c & 31, ob = rr * 64 + cc * 2; return st * 1024 + (ob ^ (((ob >> 9) & 1) << 5)); }
__host__ __device__ __forceinline__ void stage_rc(int b, int& R, int& C) { const int st = b / 1024, sb = b % 1024, swz = sb ^ (((sb >> 9) & 1) << 5); R = (st >> 1) * 16 + swz / 64; C = (st & 1) * 32 + (swz % 64) / 2; }
__host__ __device__ __forceinline__ int perm32(int rho) { const int n = rho >> 4, i = rho & 15; return 8 * (i >> 2) + 4 * n + (i & 3); }

struct Unit { int pm, pn, k0, nt, ks; };
struct Gemm { const bf16_t* A; const bf16_t* Bt; int M, N, K; };

struct StaticOrder {
    int nM, nN, nwg, G, c, ntk, WGM;
    __host__ __device__ void init(int M, int N, int G_, int c_, int K, int wgm = 4) { nM = M / BM; nN = N / BM; nwg = nM * nN; G = G_; c = c_; ntk = K / BK; WGM = wgm; }
    __host__ __device__ __forceinline__ void tile_of(int wgid, int& pm, int& pn) const {
        { const int q = nwg / NXCD, r = nwg % NXCD, xcd = wgid % NXCD, off = wgid / NXCD; wgid = (xcd < r ? xcd * (q + 1) : r * (q + 1) + (xcd - r) * q) + off; }
        const int nig = WGM * nN, gid = wgid / nig, fm = gid * WGM, gsz = (nM - fm) < WGM ? (nM - fm) : WGM;
        pm = fm + ((wgid % nig) % gsz); pn = (wgid % nig) / gsz; }
    __host__ __device__ __forceinline__ bool next(int i, Unit& u) const {
        const long L = (long)i * G + c; const bool ok = L < nwg;
        int pm = 0, pn = 0; tile_of(ok ? (int)L : 0, pm, pn);
        u.pm = pm; u.pn = pn; u.k0 = 0; u.nt = ntk; u.ks = -1; return ok;
    }
    __device__ __forceinline__ void a_ready(const Unit&) const {}
    __device__ __forceinline__ void done(const Unit&) const {}
};
struct CtxColsOrder {
    StaticOrder lat; int NL, NC, nc, c0, ctx_pm0;
    __host__ __device__ void init(int M_lat, int N, int G_, int c_, int K, int ctx_pm0_, int c0_, int nc_, int wgm = 4) { lat.init(M_lat, N, G_, c_, K, wgm); NL = lat.nwg; ctx_pm0 = ctx_pm0_; c0 = c0_; nc = nc_; NC = 4 * nc_; }
    __host__ __device__ __forceinline__ bool next(int i, Unit& u) const {
        const long L = (long)i * lat.G + lat.c; const bool isl = L < NL; const long jl = L - NL; const bool isc = !isl && jl < NC;
        int pm = 0, pn = 0; lat.tile_of(isl ? (int)L : 0, pm, pn);
        if (isc) { const int j = (int)jl; pn = c0 + j % nc; pm = ctx_pm0 + j / nc; }
        u.pm = pm; u.pn = pn; u.k0 = 0; u.nt = lat.ntk; u.ks = -1; return isl || isc;
    }
    __device__ __forceinline__ void a_ready(const Unit&) const {}
    __device__ __forceinline__ void done(const Unit&) const {}
};
struct CtxSplitOrder {
    StaticOrder lat; int NL, NC, nN, ctx_pm0, kslice;
    __host__ __device__ void init(int M_lat, int N, int G_, int c_, int K, int nsplit  , int ctx_pm0_, int wgm = 4) {
        lat.init(M_lat, N, G_, c_, K, wgm); NL = lat.nwg; nN = N / BM; ctx_pm0 = ctx_pm0_; NC = nsplit ? 4 * nN * nsplit : 0; kslice = nsplit ? K / nsplit : K; }
    __host__ __device__ __forceinline__ bool next(int i, Unit& u) const {
        const long L = (long)i * lat.G + lat.c; const bool isl = L < NL; const long jl = L - NL; const bool isc = !isl && jl < NC;
        int pm = 0, pn = 0; lat.tile_of(isl ? (int)L : 0, pm, pn);
        int k0 = 0, nt = lat.ntk, ks = -1;
        if (isc) { const int j = (int)jl, nsp = NC / (4 * nN); ks = j % nsp; const int r = j / nsp; pn = r % nN; pm = ctx_pm0 + r / nN; k0 = ks * kslice; nt = kslice / BK; }
        u.pm = pm; u.pn = pn; u.k0 = k0; u.nt = nt; u.ks = ks; return isl || isc;
    }
    __device__ __forceinline__ void a_ready(const Unit&) const {}
    __device__ __forceinline__ void done(const Unit&) const {}
};

__device__ __forceinline__ float xsum16(float v) { const unsigned x = __builtin_bit_cast(unsigned, v); const auto r = __builtin_amdgcn_permlane16_swap(x, x, false, false); return __builtin_bit_cast(float, (unsigned)r[0]) + __builtin_bit_cast(float, (unsigned)r[1]); }
__device__ __forceinline__ float xsum32(float v) { const unsigned x = __builtin_bit_cast(unsigned, v); const auto r = __builtin_amdgcn_permlane32_swap(x, x, false, false); return __builtin_bit_cast(float, (unsigned)r[0]) + __builtin_bit_cast(float, (unsigned)r[1]); }
__device__ __forceinline__ unsigned cvt_pk_bf16(float lo, float hi) { unsigned r; asm volatile("v_cvt_pk_bf16_f32 %0, %1, %2" : "=v"(r) : "v"(lo), "v"(hi)); return r; }

template <int ACT  , bool PROD = false> struct EpiBf16 {
    static constexpr bool PERM = true, AFTER_DRAIN = false, MIDK = false;
    bf16_t* O; int ldc; const float* rstd; const float* bias; int bstride;
    int prod_pn0 = 1 << 30, prod_col0 = 0;
    __device__ __forceinline__ void operator()(const f32x4 (&acc)[2][2][4][2], const Unit& u, int wr, int wc, int fr, int fq) const {
        const int row0 = u.pm * BM + wr * 64 + fr; const int col0 = u.pn * BM + wc * 32 + 8 * fq;
        const float* bp = bias + (size_t)(u.pm < 128 ? (u.pm >> 5) : 4) * bstride + col0;
        f32x4 bv[2][2];
#pragma unroll
        for (int bj = 0; bj < 2; ++bj)
#pragma unroll
            for (int n = 0; n < 2; ++n) bv[bj][n] = *(const f32x4*)(bp + bj * HALF + 4 * n);
        float rv[2];
#pragma unroll
        for (int ai = 0; ai < 2; ++ai) rv[ai] = rstd[u.pm * BM + ai * HALF + wr * 64 + fr + 16 * fq];
        float rb[2][4];
#pragma unroll
        for (int ai = 0; ai < 2; ++ai) { const unsigned x = __builtin_bit_cast(unsigned, rv[ai]);
            const auto r16 = __builtin_amdgcn_permlane16_swap(x, x, false, false);
            const unsigned e = r16[0], o = r16[1];
            const auto pe = __builtin_amdgcn_permlane32_swap(e, e, false, false), po = __builtin_amdgcn_permlane32_swap(o, o, false, false);
            rb[ai][0] = __builtin_bit_cast(float, (unsigned)pe[0]); rb[ai][2] = __builtin_bit_cast(float, (unsigned)pe[1]);
            rb[ai][1] = __builtin_bit_cast(float, (unsigned)po[0]); rb[ai][3] = __builtin_bit_cast(float, (unsigned)po[1]); }
        const unsigned voff = (unsigned)(fr * ldc + 8 * fq) * 2u;
        if (PROD && u.pn >= prod_pn0) {
#pragma unroll
            for (int ai = 0; ai < 2; ++ai)
#pragma unroll
                for (int m = 0; m < 4; ++m) { bf16_t* rowp = (bf16_t*)((char*)(O + (size_t)(u.pm * BM + wr * 64 + ai * HALF + m * 16) * ldc + prod_col0 + 128 * (u.pn - prod_pn0) + wc * 32) + voff);
                    const float r = rb[ai][m];
                    const f32x4 p0 = (acc[ai][0][m][0] * r + bv[0][0]) * (acc[ai][1][m][0] * r + bv[1][0]), p1 = (acc[ai][0][m][1] * r + bv[0][1]) * (acc[ai][1][m][1] * r + bv[1][1]);
                    u32x4 w; w.x = cvt_pk_bf16(p0[0], p0[1]); w.y = cvt_pk_bf16(p0[2], p0[3]); w.z = cvt_pk_bf16(p1[0], p1[1]); w.w = cvt_pk_bf16(p1[2], p1[3]);
                    *(u32x4*)rowp = w; }
            return; }
#pragma unroll
        for (int ai = 0; ai < 2; ++ai)
#pragma unroll
            for (int m = 0; m < 4; ++m) { bf16_t* rowp = (bf16_t*)((char*)(O + (size_t)(u.pm * BM + wr * 64 + ai * HALF + m * 16) * ldc + u.pn * BM + wc * 32) + voff);
                const float r = rb[ai][m];
#pragma unroll
                for (int bj = 0; bj < 2; ++bj) { f32x4 v0 = acc[ai][bj][m][0] * r + bv[bj][0], v1 = acc[ai][bj][m][1] * r + bv[bj][1];
                    if (ACT == 2) {
#pragma unroll
                        for (int e = 0; e < 4; ++e) { const float a = fmaxf(v0[e], 0.f), b = fmaxf(v1[e], 0.f); v0[e] = a * a; v1[e] = b * b; } }
                    u32x4 w; w.x = cvt_pk_bf16(v0[0], v0[1]); w.y = cvt_pk_bf16(v0[2], v0[3]); w.z = cvt_pk_bf16(v1[0], v1[1]); w.w = cvt_pk_bf16(v1[2], v1[3]);
                    *(u32x4*)(rowp + bj * HALF) = w; } }
    }
};

struct EpiGateRes {
    static constexpr bool PERM = true, AFTER_DRAIN = false, MIDK = false;
    const float* base_f32; const bf16_t* base_bf; bf16_t* out; const float* gate; int ldc; int gstride;
    bf16_t* a2; float* ssq; int ssq_stride; const float* cs_g; const float* cs_sc;
    __device__ __forceinline__ void operator()(const f32x4 (&acc)[2][2][4][2], const Unit& u, int wr, int wc, int fr, int fq) const {
        const int col0 = u.pn * BM + wc * 32 + 8 * fq;
        const int mrow = u.pm >> 5;
        const float* gb = gate + (size_t)mrow * gstride + col0;
        const size_t roff = (size_t)(u.pm * BM + wr * 64 + fr) * ldc + col0;
        f32x4 gv[2][2], cv[2][2];
#pragma unroll
        for (int bj = 0; bj < 2; ++bj)
#pragma unroll
            for (int n = 0; n < 2; ++n) { gv[bj][n] = *(const f32x4*)(gb + bj * HALF + 4 * n);
                if (a2) cv[bj][n] = *(const f32x4*)(cs_g + col0 + bj * HALF + 4 * n) * (*(const f32x4*)(cs_sc + (size_t)mrow * gstride + col0 + bj * HALF + 4 * n) + 1.0f);
                else cv[bj][n] = (f32x4){0.f, 0.f, 0.f, 0.f}; }
#pragma unroll
        for (int gi = 0; gi < 8; ++gi) { const int ai = gi >> 2, m = gi & 3; const size_t off = (size_t)(ai * HALF + m * 16) * ldc;
            f32x4 bs[2][2];
            if (base_f32) {
#pragma unroll
                for (int bj = 0; bj < 2; ++bj)
#pragma unroll
                    for (int n = 0; n < 2; ++n) bs[bj][n] = *(const f32x4*)(base_f32 + roff + off + bj * HALF + 4 * n);
            } else {
#pragma unroll
                for (int bj = 0; bj < 2; ++bj) { const u32x4 r = *(const u32x4*)(base_bf + roff + off + bj * HALF);
                    bs[bj][0] = (f32x4){__uint_as_float(r.x << 16), __uint_as_float(r.x & 0xffff0000u), __uint_as_float(r.y << 16), __uint_as_float(r.y & 0xffff0000u)};
                    bs[bj][1] = (f32x4){__uint_as_float(r.z << 16), __uint_as_float(r.z & 0xffff0000u), __uint_as_float(r.w << 16), __uint_as_float(r.w & 0xffff0000u)}; }
            }
            float ss = 0.f;
#pragma unroll
            for (int bj = 0; bj < 2; ++bj) { f32x4 x[2];
#pragma unroll
                for (int n = 0; n < 2; ++n) { x[n] = bs[bj][n] + gv[bj][n] * acc[ai][bj][m][n];
                    ss += (x[n][0] * x[n][0] + x[n][1] * x[n][1]) + (x[n][2] * x[n][2] + x[n][3] * x[n][3]); }
                { u32x4 w; w.x = cvt_pk_bf16(x[0][0], x[0][1]); w.y = cvt_pk_bf16(x[0][2], x[0][3]); w.z = cvt_pk_bf16(x[1][0], x[1][1]); w.w = cvt_pk_bf16(x[1][2], x[1][3]);
                  *(u32x4*)(out + roff + off + bj * HALF) = w; }
                if (a2) { const f32x4 y0 = x[0] * cv[bj][0], y1 = x[1] * cv[bj][1];
                    u32x4 w; w.x = cvt_pk_bf16(y0[0], y0[1]); w.y = cvt_pk_bf16(y0[2], y0[3]); w.z = cvt_pk_bf16(y1[0], y1[1]); w.w = cvt_pk_bf16(y1[2], y1[3]);
                    *(u32x4*)(a2 + roff + off + bj * HALF) = w; } }
            if (a2) { ss = xsum16(ss); ss = xsum32(ss);
                if (fq == 0) ssq[(size_t)(u.pn * 4 + wc) * ssq_stride + u.pm * BM + wr * 64 + fr + ai * HALF + m * 16] = ss; }
            if (gi & 1) asm volatile("" ::: "memory"); }
    }
};
struct EpiGateResSplit {
    static constexpr bool PERM = true, AFTER_DRAIN = false, MIDK = false;
    EpiGateRes whole; float* part; int ctx_pm0; int ldc;
    __device__ __forceinline__ void operator()(const f32x4 (&acc)[2][2][4][2], const Unit& u, int wr, int wc, int fr, int fq) const {
        if (u.ks < 0) { whole(acc, u, wr, wc, fr, fq); return; }
        float* op = part + ((size_t)u.ks * 4 * BM + (size_t)(u.pm - ctx_pm0) * BM + wr * 64 + fr) * ldc + u.pn * BM + wc * 32 + 8 * fq;
#pragma unroll
        for (int ai = 0; ai < 2; ++ai)
#pragma unroll
            for (int m = 0; m < 4; ++m) { const size_t off = (size_t)(ai * HALF + m * 16) * ldc;
#pragma unroll
                for (int bj = 0; bj < 2; ++bj)
#pragma unroll
                    for (int n = 0; n < 2; ++n) *(f32x4*)(op + off + bj * HALF + 4 * n) = acc[ai][bj][m][n]; }
    }
};
struct EpiGateResSplitMid {
    static constexpr bool PERM = true, AFTER_DRAIN = false, MIDK = true;
    EpiGateResSplit base; const float* rna;
    __device__ __forceinline__ void operator()(const f32x4 (&acc)[2][2][4][2], const Unit& u, int wr, int wc, int fr, int fq) const { base(acc, u, wr, wc, fr, fq); }
    __device__ __forceinline__ void mid_load(float (&rv)[2], const Unit& u, int wr, int fr, int fq) const {
#pragma unroll
        for (int ai = 0; ai < 2; ++ai) rv[ai] = u.ks < 0 ? rna[u.pm * BM + ai * HALF + wr * 64 + fr + 16 * fq] : 1.0f; }
    __device__ __forceinline__ void mid(f32x4 (&acc)[2][2][4][2], const float (&rvv)[2]) const {
        float rb[2][4];
#pragma unroll
        for (int ai = 0; ai < 2; ++ai) { const unsigned x = __builtin_bit_cast(unsigned, rvv[ai]);
            const auto r16 = __builtin_amdgcn_permlane16_swap(x, x, false, false);
            const unsigned e = r16[0], o = r16[1];
            const auto pe = __builtin_amdgcn_permlane32_swap(e, e, false, false), po = __builtin_amdgcn_permlane32_swap(o, o, false, false);
            rb[ai][0] = __builtin_bit_cast(float, (unsigned)pe[0]); rb[ai][2] = __builtin_bit_cast(float, (unsigned)pe[1]);
            rb[ai][1] = __builtin_bit_cast(float, (unsigned)po[0]); rb[ai][3] = __builtin_bit_cast(float, (unsigned)po[1]); }
#pragma unroll
        for (int ai = 0; ai < 2; ++ai)
#pragma unroll
            for (int m = 0; m < 4; ++m)
#pragma unroll
                for (int bj = 0; bj < 2; ++bj)
#pragma unroll
                    for (int n = 0; n < 2; ++n) acc[ai][bj][m][n] = acc[ai][bj][m][n] * rb[ai][m];
    }
};

template <class Epi, class Sched, bool ALIGN_EPI = false, bool SP2 = false>
__device__ __forceinline__ void gemm_phase(PG8_LAS unsigned char* lds, const Gemm g, const Sched& S, const Epi& E, const int tid_in) {
    const int tid = tid_in, wid = __builtin_amdgcn_readfirstlane(tid >> 6), lane = tid & 63, wr = wid >> 2, wc = wid & 3, fr = lane & 15, fq = lane >> 4;
    const int K = g.K;
    unsigned voffA[2], voffB[2];
#pragma unroll
    for (int i = 0; i < 2; ++i) { int R, C; stage_rc(tid * 16 + i * 8192, R, C); const int Rb = Epi::PERM ? ((R & ~31) + perm32(R & 31)) : R;
        voffA[i] = (unsigned)(R * K + C) * 2u; voffB[i] = (unsigned)(Rb * K + C) * 2u; }
    const size_t kstep = (size_t)(BK * 2);
    const size_t hstep = (size_t)HALF * K * 2;
    const size_t tstep = 2 * hstep;
    const unsigned ldsw = (unsigned)wid * 1024u;
    const int aoff = lds_byte(wr * 64 + fr, fq * 8), boff = lds_byte(wc * 32 + fr, fq * 8);
#define PG8_SA(b, h) (((b) * 2 + (h)) * HTB)
#define PG8_SB(b, h) ((4 + (b) * 2 + (h)) * HTB)
#define PG8_STAGE(bufoff, gbase, voff) do { _Pragma("unroll") for (int _i = 0; _i < 2; ++_i) \
        __builtin_amdgcn_global_load_lds((const unsigned*)((const char*)(gbase) + (voff)[_i]), (PG8_LAS unsigned*)(lds + (bufoff) + ldsw + _i * 8192), 16, 0, 0); } while (0)
#define PG8_LDA(dst, b, h) do { _Pragma("unroll") for (int m = 0; m < 4; ++m) _Pragma("unroll") for (int k = 0; k < 2; ++k) dst[m][k] = *(const PG8_LAS bf16x8*)(lds + PG8_SA(b, h) + aoff + m * 2048 + k * 1024); } while (0)
#define PG8_LDB(dst, b, h) do { _Pragma("unroll") for (int n = 0; n < 2; ++n) _Pragma("unroll") for (int k = 0; k < 2; ++k) dst[n][k] = *(const PG8_LAS bf16x8*)(lds + PG8_SB(b, h) + boff + n * 2048 + k * 1024); } while (0)
#define PG8_MMA(ai, bj, At, Bt) do { __builtin_amdgcn_s_setprio(1); _Pragma("unroll") for (int m = 0; m < 4; ++m) _Pragma("unroll") for (int n = 0; n < 2; ++n) _Pragma("unroll") for (int k = 0; k < 2; ++k) \
        acc[ai][bj][m][n] = __builtin_amdgcn_mfma_f32_16x16x32_bf16(Bt[n][k], At[m][k], acc[ai][bj][m][n], 0, 0, 0); __builtin_amdgcn_s_setprio(0); } while (0)
#define PG8_WAIT_V(n) asm volatile("s_waitcnt vmcnt(" #n ")" ::: "memory")
#define PG8_WAIT_L(n) asm volatile("s_waitcnt lgkmcnt(" #n ")" ::: "memory")
#define PG8_BAR __builtin_amdgcn_s_barrier()
#define PG8_SCHED __builtin_amdgcn_sched_barrier(0)
    Unit cur, nxt; int ui = 0;
    if (!S.next(0, cur)) return;
    f32x4 acc[2][2][4][2];
#pragma unroll
    for (int a = 0; a < 2; ++a)
#pragma unroll
        for (int b = 0; b < 2; ++b)
#pragma unroll
            for (int m = 0; m < 4; ++m)
#pragma unroll
                for (int n = 0; n < 2; ++n) acc[a][b][m][n] = (f32x4){0.f, 0.f, 0.f, 0.f};
    bf16x8 At[4][2], B0[2][2], B1[2][2];
    const char* cA = (const char*)g.A + (size_t)cur.pm * tstep + (size_t)cur.k0 * 2; const char* cB = (const char*)g.Bt + (size_t)cur.pn * tstep + (size_t)cur.k0 * 2;
    S.a_ready(cur);
    if constexpr (SP2) {
        PG8_STAGE(PG8_SB(0, 0), cB, voffB); PG8_STAGE(PG8_SB(0, 1), cB + hstep, voffB); PG8_STAGE(PG8_SA(0, 0), cA, voffA); PG8_STAGE(PG8_SA(0, 1), cA + hstep, voffA);
        if (wr == 1) PG8_BAR;
        PG8_WAIT_V(2); PG8_BAR;
        PG8_STAGE(PG8_SB(1, 0), cB + kstep, voffB); PG8_STAGE(PG8_SA(1, 0), cA + kstep, voffA); PG8_STAGE(PG8_SB(1, 1), cB + hstep + kstep, voffB);
        PG8_WAIT_V(6); PG8_BAR;
    } else {
        PG8_STAGE(PG8_SB(0, 0), cB, voffB); PG8_STAGE(PG8_SA(0, 0), cA, voffA); PG8_STAGE(PG8_SB(0, 1), cB + hstep, voffB); PG8_STAGE(PG8_SA(0, 1), cA + hstep, voffA);
        if (wr == 1) PG8_BAR;
        PG8_WAIT_V(4); PG8_BAR;
        PG8_STAGE(PG8_SB(1, 0), cB + kstep, voffB); PG8_STAGE(PG8_SA(1, 0), cA + kstep, voffA); PG8_STAGE(PG8_SB(1, 1), cB + hstep + kstep, voffB);
        PG8_WAIT_V(6); PG8_BAR;
    }
    for (;;) {
        const bool has_next = S.next(ui + 1, nxt);
        const char* nA = has_next ? (const char*)g.A + (size_t)nxt.pm * tstep + (size_t)nxt.k0 * 2 : cA; const char* nB = has_next ? (const char*)g.Bt + (size_t)nxt.pn * tstep + (size_t)nxt.k0 * 2 : cB;
        const int nt = cur.nt;
        const int npass = Epi::MIDK ? 2 : 1;
        float mrv[2] = {1.0f, 1.0f};
        if constexpr (Epi::MIDK) E.mid_load(mrv, cur, wr, fr, fq);
#pragma unroll 1
        for (int ps = 0; ps < npass; ++ps) {
        const int t_lo = (Epi::MIDK && ps == 1) ? nt / 2 : 0, t_hi = (Epi::MIDK && ps == 0) ? nt / 2 : nt;
        for (int t = t_lo; t < t_hi; t += 2) {
            const bool last = (t == nt - 2);
            const char* a1 = cA + (size_t)(t + 1) * kstep;
            const char* a2 = last ? nA : cA + (size_t)(t + 2) * kstep; const char* b2 = last ? nB : cB + (size_t)(t + 2) * kstep;
            const char* a3 = a2 + kstep; const char* b3 = b2 + kstep;
            if (last && has_next) S.a_ready(nxt);
            if constexpr (SP2) {
            PG8_LDB(B0, 0, 0); PG8_LDB(B1, 0, 1); PG8_SCHED; PG8_LDA(At, 0, 0); PG8_STAGE(PG8_SA(1, 1), a1 + hstep, voffA);
            PG8_WAIT_V(8); PG8_WAIT_L(0); PG8_BAR; PG8_MMA(0, 0, At, B0); PG8_MMA(0, 1, At, B1); PG8_BAR; PG8_SCHED;
            PG8_LDA(At, 0, 1); PG8_STAGE(PG8_SB(0, 0), b2, voffB); PG8_STAGE(PG8_SB(0, 1), b2 + hstep, voffB); PG8_STAGE(PG8_SA(0, 0), a2, voffA);
            PG8_WAIT_V(8); PG8_WAIT_L(0); PG8_BAR; PG8_MMA(1, 0, At, B0); PG8_MMA(1, 1, At, B1); PG8_BAR; PG8_SCHED;
            PG8_LDB(B0, 1, 0); PG8_LDB(B1, 1, 1); PG8_SCHED; PG8_LDA(At, 1, 0); PG8_STAGE(PG8_SA(0, 1), a2 + hstep, voffA);
            PG8_WAIT_V(8); PG8_WAIT_L(0); PG8_BAR; PG8_MMA(0, 0, At, B0); PG8_MMA(0, 1, At, B1); PG8_BAR; PG8_SCHED;
            PG8_LDA(At, 1, 1); PG8_STAGE(PG8_SB(1, 0), b3, voffB); PG8_STAGE(PG8_SB(1, 1), b3 + hstep, voffB); PG8_STAGE(PG8_SA(1, 0), a3, voffA);
            PG8_WAIT_V(8); PG8_WAIT_L(0); PG8_BAR; PG8_MMA(1, 0, At, B0); PG8_MMA(1, 1, At, B1); PG8_BAR; PG8_SCHED;
            } else {
            PG8_LDB(B0, 0, 0); PG8_SCHED; PG8_LDA(At, 0, 0); PG8_STAGE(PG8_SA(1, 1), a1 + hstep, voffA);
            PG8_WAIT_L(8); PG8_BAR; PG8_WAIT_L(0); PG8_MMA(0, 0, At, B0); PG8_BAR; PG8_SCHED;
            PG8_LDB(B1, 0, 1); PG8_STAGE(PG8_SB(0, 0), b2, voffB);
            PG8_BAR; PG8_WAIT_L(0); PG8_MMA(0, 1, At, B1); PG8_BAR;
            PG8_LDA(At, 0, 1); PG8_STAGE(PG8_SA(0, 0), a2, voffA);
            PG8_BAR; PG8_WAIT_L(0); PG8_MMA(1, 0, At, B0); PG8_BAR; PG8_SCHED;
            PG8_STAGE(PG8_SB(0, 1), b2 + hstep, voffB);
            PG8_WAIT_V(6); PG8_BAR; PG8_MMA(1, 1, At, B1); PG8_BAR;
            PG8_LDB(B0, 1, 0); PG8_SCHED; PG8_LDA(At, 1, 0); PG8_STAGE(PG8_SA(0, 1), a2 + hstep, voffA);
            PG8_WAIT_L(8); PG8_BAR; PG8_WAIT_L(0); PG8_MMA(0, 0, At, B0); PG8_BAR; PG8_SCHED;
            PG8_LDB(B1, 1, 1); PG8_STAGE(PG8_SB(1, 0), b3, voffB);
            PG8_BAR; PG8_WAIT_L(0); PG8_MMA(0, 1, At, B1); PG8_BAR;
            PG8_LDA(At, 1, 1); PG8_STAGE(PG8_SA(1, 0), a3, voffA);
            PG8_BAR; PG8_WAIT_L(0); PG8_MMA(1, 0, At, B0); PG8_BAR; PG8_SCHED;
            PG8_STAGE(PG8_SB(1, 1), b3 + hstep, voffB);
            PG8_WAIT_V(6); PG8_BAR; PG8_MMA(1, 1, At, B1); PG8_BAR;
            }
        }
        if constexpr (Epi::MIDK) { if (ps == 0) E.mid(acc, mrv); }
        }
        if constexpr (ALIGN_EPI) { if (wr == 0) PG8_BAR; }
        if constexpr (!Epi::AFTER_DRAIN) { E(acc, cur, wr, wc, fr, fq); S.done(cur); }
        if (!has_next) break;
#pragma unroll
        for (int a = 0; a < 2; ++a)
#pragma unroll
            for (int b = 0; b < 2; ++b)
#pragma unroll
                for (int m = 0; m < 4; ++m)
#pragma unroll
                    for (int n = 0; n < 2; ++n) acc[a][b][m][n] = (f32x4){0.f, 0.f, 0.f, 0.f};
        cur = nxt; cA = nA; cB = nB; ++ui;
        if constexpr (ALIGN_EPI) { if (wr == 1) PG8_BAR; }
    }
    PG8_WAIT_V(0);
    if constexpr (!ALIGN_EPI) { if (wr == 0) PG8_BAR; }
    PG8_BAR;
    if constexpr (Epi::AFTER_DRAIN) { E.fused(acc, cur, wr, wc, fr, fq, lds, wid, lane); S.done(cur); }
#undef PG8_SA
#undef PG8_SB
#undef PG8_STAGE
#undef PG8_LDA
#undef PG8_LDB
#undef PG8_MMA
#undef PG8_WAIT_V
#undef PG8_WAIT_L
#undef PG8_BAR
#undef PG8_SCHED
}
}

constexpr int NWAVES = 8;
#ifndef MK_PER_PHASE
#define MK_PER_PHASE 0
#endif

constexpr int DM = 2048, NB = 4, SEQ = 8192, DEPTH = 4, CTXL = 256, GRID_W = 64, GRID_R = SEQ / GRID_W;
constexpr int NAW = 1024, NH = 8, HD = 128, CVW = 1024, INC = 6144, DFF = 8192, NMOD = 6, MODW = NMOD * DM;
constexpr int WIN_R = 8, WIN_C = 16, RPB_R = 2 * WIN_R - 1, RPB_C = 2 * WIN_C - 1, RPB_HS = RPB_R * RPB_C;
constexpr int MLAT = NB * SEQ, MCTX = NB * CTXL, MT = MLAT + MCTX;
constexpr float EPS = 1e-6f;
constexpr int COL_Q = 0, COL_K = NAW, COL_V = 2 * NAW, COL_BG = 3 * NAW, COL_CG = 3 * NAW + CVW, COL_U = 3 * NAW + 2 * CVW;
constexpr int PPITCH = INC + 64;
constexpr int N_PHASES = 2 + 7 * DEPTH;

constexpr size_t MiB = 1u << 20;
constexpr size_t WS_CTL = 0, CTL_ZERO_BYTES = 1 * MiB;
constexpr size_t WS_MOD = 1 * MiB;
constexpr size_t WS_VEC = 2 * MiB;
constexpr size_t WS_WIN = 3 * MiB, WS_WOUT = 99 * MiB, WS_W1 = 131 * MiB, WS_W2 = 259 * MiB;
constexpr size_t WS_X = 387 * MiB;
constexpr size_t WS_XN = 651 * MiB;
constexpr size_t WS_P = 783 * MiB;
constexpr size_t WS_MIX = 1184 * MiB;
constexpr size_t WS_H = 783 * MiB;
constexpr size_t WS_PO = 1316 * MiB, WS_PM = 1380 * MiB;
constexpr size_t WS_SSQ = 1444 * MiB, SSQ_BYTES = 2 * MiB;
constexpr size_t WS_SHW = 1446 * MiB;
constexpr size_t WS_SSQP = 1448 * MiB;
constexpr size_t WS_END = 1454 * MiB;
constexpr int NSPLIT = 8;
constexpr int VEC_G1 = 0, VEC_G2 = DM, VEC_RPB = 2 * DM, VEC_CW = VEC_RPB + 3728, VEC_GNA = VEC_CW + 3 * CVW, VEC_GCV = VEC_GNA + NAW, VEC_L = VEC_GCV + CVW, VEC_GF = DEPTH * VEC_L;
static_assert(NH * RPB_HS <= 3728 && (size_t)(VEC_GF + DM) * 4 <= MiB && VEC_CW % 4 == 0 && VEC_L % 4 == 0, "VEC map");
static_assert((size_t)DEPTH * 5 * MODW * 4 <= MiB && WS_WIN + (size_t)DEPTH * INC * DM * 2 <= WS_WOUT && WS_WOUT + (size_t)DEPTH * DM * DM * 2 <= WS_W1 && WS_W1 + (size_t)DEPTH * DFF * DM * 2 <= WS_W2 &&
              WS_W2 + (size_t)DEPTH * DFF * DM * 2 <= WS_X && WS_X + (size_t)MT * DM * 4 <= WS_XN && WS_XN + (size_t)MT * DM * 2 <= WS_P && WS_P + (size_t)MT * PPITCH * 2 <= WS_MIX &&
              WS_MIX + (size_t)MT * DM * 2 <= WS_PO && WS_H + (size_t)MT * DFF * 2 <= WS_PO && WS_PO + (size_t)NSPLIT * MCTX * DM * 4 <= WS_PM && WS_PM + (size_t)NSPLIT * MCTX * DM * 4 <= WS_SSQ && (size_t)DEPTH * 2 * MT * 4 <= SSQ_BYTES && WS_SHW + (size_t)DEPTH * 5 * (INC + DFF) * 4 <= WS_SSQP && WS_SSQP + (size_t)32 * MT * 4 <= WS_END, "d_ws map");
constexpr int CW_BAR = 4096;

constexpr int RING_OFF = 0, RING_BYTES = 131072;
constexpr int LDSCTL_OFF = RING_BYTES, MISC_OFF = LDSCTL_OFF + 320;
constexpr int LDS_BYTES = 147456;
static_assert(MISC_OFF + 128 <= LDS_BYTES, "LDS map");

#define GAS __attribute__((address_space(1)))
#define LAS __attribute__((address_space(3)))
typedef unsigned short bf16;
typedef unsigned v4u __attribute__((ext_vector_type(4)));
typedef float f32x4 __attribute__((ext_vector_type(4)));
typedef short bf16x8 __attribute__((ext_vector_type(8)));
typedef GAS unsigned gu32;
typedef GAS unsigned long long gu64;
#define RLX_AGENT __ATOMIC_RELAXED, __HIP_MEMORY_SCOPE_AGENT
#define LDS_WAIT() asm volatile("s_waitcnt lgkmcnt(0)" ::: "memory")
#define VM_WAIT() asm volatile("s_waitcnt vmcnt(0)" ::: "memory")
__device__ __forceinline__ unsigned long long rt() { return __builtin_amdgcn_s_memrealtime(); }
__device__ __forceinline__ unsigned f2bf(float f) { unsigned u = __builtin_bit_cast(unsigned, f); return (u + 0x7fffu + ((u >> 16) & 1u)) >> 16; }
__device__ __forceinline__ unsigned pk2(float lo, float hi) { return f2bf(lo) | (f2bf(hi) << 16); }

#define XB_TMO      128
#define XB_XCNT(j)  (256  + 64 * (j))
#define XB_XSUB(j)  (1280 + 64 * (j))
#define XB_XGEN(j)  (2304 + 64 * (j))
#define XB_TOP      3328
#define XB_TOPGEN   3392
#define XCD_BAR_WORDS 3456
#define XB_SPIN_CAP (1u << 18)

__device__ __forceinline__ unsigned xb_ld(unsigned* p)              { return __hip_atomic_load(p, __ATOMIC_RELAXED, __HIP_MEMORY_SCOPE_AGENT); }
__device__ __forceinline__ unsigned xb_add(unsigned* p, unsigned v) { return __hip_atomic_fetch_add(p, v, __ATOMIC_RELAXED, __HIP_MEMORY_SCOPE_AGENT); }
__device__ __forceinline__ unsigned xb_xcc_id() { return (unsigned)__builtin_amdgcn_s_getreg((3 << 11) | 20) & 0xFu; }
#define XB_SPIN(cond, bar) do { unsigned _sp = 0; while (cond) { __builtin_amdgcn_s_sleep(1); \
    if ((++_sp & 255u) == 0u) { if (xb_ld(&(bar)[XB_TMO])) break; if (_sp > XB_SPIN_CAP) { atomicAdd(&(bar)[XB_TMO], 1u); break; } } } } while (0)

struct XcdBarrier {
    unsigned* bar; unsigned x;
    volatile LAS unsigned* st;
};

__device__ __forceinline__ XcdBarrier xcd_barrier_post(unsigned* bar, volatile LAS unsigned* st) {
    XcdBarrier b; b.bar = bar; b.x = xb_xcc_id(); b.st = st;
    if (threadIdx.x == 0) (void)xb_add(&bar[XB_XCNT(b.x)], 1u);
    return b;
}
__device__ __forceinline__ void xcd_barrier_complete(unsigned* bar, unsigned x, unsigned& nloc, unsigned& nx) {
    const unsigned G = gridDim.x * gridDim.y * gridDim.z;
    unsigned sum, cnt, mine, sp = 0u;
    for (;;) {
        sum = 0u; cnt = 0u; mine = 0u;
#pragma unroll
        for (unsigned j = 0; j < 16; ++j) { const unsigned c = xb_ld(&bar[XB_XCNT(j)]); sum += c; cnt += (c > 0u) ? 1u : 0u; mine = (j == x) ? c : mine; }
        if (sum == G) break;
        __builtin_amdgcn_s_sleep(1);
        if ((++sp & 255u) == 0u) { if (xb_ld(&bar[XB_TMO])) break; if (sp > XB_SPIN_CAP) { atomicAdd(&bar[XB_TMO], 1u); break; } }
    }
    nloc = mine > 0u ? mine : 1u; nx = cnt > 0u ? cnt : 1u;
}

__device__ __forceinline__ void xcd_barrier(const XcdBarrier& b) {
    asm volatile("s_waitcnt vmcnt(0)" ::: "memory");
    __syncthreads();
    if (threadIdx.x == 0) {
        unsigned* bar = b.bar;
        __builtin_amdgcn_s_waitcnt(0);
        unsigned nloc = b.st[0], nx = b.st[1];
        if (nloc == 0u) { xcd_barrier_complete(bar, b.x, nloc, nx); b.st[0] = nloc; b.st[1] = nx; }
        const unsigned old = xb_add(&bar[XB_XSUB(b.x)], 1u);
        const unsigned gen = old / nloc;
        if (old + 1u == (gen + 1u) * nloc) {
            __builtin_amdgcn_fence(__ATOMIC_RELEASE, "agent");
            asm volatile("s_waitcnt vmcnt(0)" ::: "memory");
            const unsigned og = xb_add(&bar[XB_TOP], 1u);
            const unsigned tg = og / nx;
            if (og + 1u == (tg + 1u) * nx) xb_add(&bar[XB_TOPGEN], 1u);
            else XB_SPIN(xb_ld(&bar[XB_TOPGEN]) == tg, bar);
            __builtin_amdgcn_fence(__ATOMIC_ACQUIRE, "agent");
            xb_add(&bar[XB_XGEN(b.x)], 1u);
            asm volatile("s_waitcnt vmcnt(0)" ::: "memory");
        } else {
            XB_SPIN(xb_ld(&bar[XB_XGEN(b.x)]) == gen, bar);
            __builtin_amdgcn_fence(__ATOMIC_ACQUIRE, "agent");
            asm volatile("s_waitcnt vmcnt(0)" ::: "memory");
        }
    }
    __syncthreads();
}

struct Frame {
    LAS unsigned char* lds;
    volatile LAS unsigned* MISC;
    gu32* ctl;
    int tid, lane, wave;
    int vcu, G;
};
typedef unsigned u32x2 __attribute__((ext_vector_type(2)));
typedef short v4i16_t __attribute__((ext_vector_type(4)));
typedef float f32x4v __attribute__((ext_vector_type(4)));

template <int CTRL> __device__ __forceinline__ float dpp_mov(float v) { return __uint_as_float(__builtin_amdgcn_update_dpp(0u, __float_as_uint(v), CTRL, 0xF, 0xF, true)); }
__device__ __forceinline__ float x16_sum(float v) { const unsigned x = __float_as_uint(v); const auto r = __builtin_amdgcn_permlane16_swap(x, x, false, false); return __uint_as_float(r[0]) + __uint_as_float(r[1]); }
__device__ __forceinline__ float x32_sum(float v) { const unsigned x = __float_as_uint(v); const auto r = __builtin_amdgcn_permlane32_swap(x, x, false, false); return __uint_as_float(r[0]) + __uint_as_float(r[1]); }
__device__ __forceinline__ float x16_max(float v) { const unsigned x = __float_as_uint(v); const auto r = __builtin_amdgcn_permlane16_swap(x, x, false, false); return fmaxf(__uint_as_float(r[0]), __uint_as_float(r[1])); }
__device__ __forceinline__ float x32_max(float v) { const unsigned x = __float_as_uint(v); const auto r = __builtin_amdgcn_permlane32_swap(x, x, false, false); return fmaxf(__uint_as_float(r[0]), __uint_as_float(r[1])); }
__device__ __forceinline__ float wave_sum(float v) {
    v += dpp_mov<0xB1>(v);
    v += dpp_mov<0x4E>(v);
    v += dpp_mov<0x141>(v);
    v += dpp_mov<0x140>(v);
    return x32_sum(x16_sum(v));
}
__device__ __forceinline__ float bf_lo(unsigned w) { return __uint_as_float(w << 16); }
__device__ __forceinline__ float bf_hi(unsigned w) { return __uint_as_float(w & 0xffff0000u); }

struct P0Item { const float* W; bf16* WT; const float* kscale; int K, N, k0, n0, s0; };
__device__ __forceinline__ P0Item p0_item(const float* W, int K, int N, bf16* WT, int item, bool cgu, const float* kscale) {
    const int nblk = N / 32, kb = item / nblk, nb = item % nblk, k0 = 64 * kb, n0 = 32 * nb;
    int s0 = n0;
    if (cgu && n0 >= COL_CG) { const int t = (n0 - COL_CG) >> 8, c = (n0 - COL_CG) & 255; s0 = c < 128 ? COL_CG + 128 * t + c : COL_U + 128 * t + (c - 128); }
    return P0Item{W, WT, (kscale && k0 < NAW) ? kscale : (const float*)nullptr, K, N, k0, n0, s0};
}
__device__ __forceinline__ void p0_load(float (&wv)[32], const P0Item& d, int lane) {
#pragma unroll
    for (int i = 0; i < 32; ++i) { const int kk = 2 * i + (lane >> 5); wv[i] = d.W[(size_t)(d.k0 + kk) * d.N + d.s0 + (lane & 31)]; }
}
__device__ __forceinline__ void p0_process(const float (&wv)[32], const P0Item& d, LAS float* scr, int lane) {
#pragma unroll
    for (int i = 0; i < 32; ++i) { const int kk = 2 * i + (lane >> 5); float v = wv[i]; if (d.kscale) v *= d.kscale[d.k0 + kk]; scr[kk * 33 + (lane & 31)] = v; }
    LDS_WAIT(); asm volatile("" ::: "memory");
    const int c = lane & 7;
#pragma unroll
    for (int j = 0; j < 4; ++j) { const int n = (lane >> 3) + 8 * j; const LAS float* s = scr + (8 * c) * 33 + n;
        v4u o; o.x = pk2(s[0 * 33], s[1 * 33]); o.y = pk2(s[2 * 33], s[3 * 33]); o.z = pk2(s[4 * 33], s[5 * 33]); o.w = pk2(s[6 * 33], s[7 * 33]);
        *(GAS v4u*)(d.WT + (size_t)(d.n0 + n) * d.K + d.k0 + 8 * c) = o; }
    LDS_WAIT(); asm volatile("" ::: "memory");
}
struct ProIn { const float *c, *c_ctx, *w_ada, *b_ada, *w_in, *w_out, *w1, *w2, *g1, *g2, *rpb, *cw, *gna, *gcv, *gf; float* mod; float* vec; bf16 *win_t, *wout_t, *w1_t, *w2_t; };
__device__ __forceinline__ void p0_prologue(Frame& F, const ProIn& I) {
    LAS float* S = (LAS float*)(F.lds + RING_OFF);
    LAS float* RED = S + 5 * DM;
    for (int i = F.tid; i < 5 * DM; i += NWAVES * 64) { const int r = i / DM, k = i % DM; const float v = r < 4 ? I.c[r * DM + k] : I.c_ctx[k]; S[i] = v / (1.0f + __expf(-v)); }
    __syncthreads();
    constexpr int NSLAB = DEPTH * (MODW / 64);
    for (int slab = blockIdx.x; slab < NSLAB; slab += F.G) {
        const int l = slab / (MODW / 64), n0 = (slab % (MODW / 64)) * 64;
        const float* wp = I.w_ada + (size_t)l * DM * MODW + (size_t)(F.wave * 256) * MODW + n0 + F.lane;
        float a0 = 0.f, a1 = 0.f, a2 = 0.f, a3 = 0.f, a4 = 0.f;
        const LAS float* s0 = S + F.wave * 256;
#pragma unroll 32
        for (int k = 0; k < 256; ++k) { const float w = wp[(size_t)k * MODW];
            a0 += s0[k] * w; a1 += s0[DM + k] * w; a2 += s0[2 * DM + k] * w; a3 += s0[3 * DM + k] * w; a4 += s0[4 * DM + k] * w; }
        LAS float* rd = RED + F.wave * 320 + F.lane;
        rd[0] = a0; rd[64] = a1; rd[128] = a2; rd[192] = a3; rd[256] = a4;
        __syncthreads();
        if (F.tid < 320) { float s = 0.f;
#pragma unroll
            for (int w = 0; w < 8; ++w) s += RED[w * 320 + F.tid];
            const int r = F.tid >> 6, n = n0 + (F.tid & 63);
            I.mod[((size_t)l * 5 + r) * MODW + n] = s + I.b_ada[(size_t)l * MODW + n]; }
        __syncthreads();
    }
    __syncthreads();
    { const int gt = blockIdx.x * (NWAVES * 64) + F.tid, NGT = F.G * NWAVES * 64;
      for (int i = gt; i < DEPTH * VEC_L + DM; i += NGT) {
          float v;
          if (i >= VEC_GF) v = I.gf[i - VEC_GF];
          else { const int l = i / VEC_L, r = i % VEC_L;
              if (r < VEC_G2) v = I.g1[l * DM + r];
              else if (r < VEC_RPB) v = I.g2[l * DM + r - VEC_G2];
              else if (r < VEC_CW) v = (r - VEC_RPB) < NH * RPB_HS ? I.rpb[l * NH * RPB_HS + r - VEC_RPB] : 0.f;
              else if (r < VEC_GNA) v = I.cw[l * 3 * CVW + r - VEC_CW];
              else if (r < VEC_GCV) v = I.gna[l * NAW + r - VEC_GNA];
              else v = I.gcv[l * CVW + r - VEC_GCV]; }
          I.vec[i] = v; } }
    LAS float* scr = (LAS float*)(F.lds + RING_OFF + F.wave * 16384);
    const int gw = F.vcu * NWAVES + F.wave, NGW = F.G * NWAVES;
    constexpr int I_IN = (DM / 64) * (INC / 32), I_OUT = (DM / 64) * (DM / 32), I_1 = (DM / 64) * (DFF / 32), I_2 = (DFF / 64) * (DM / 32);
    constexpr int I_L = I_IN + I_OUT + I_1 + I_2, NITEMS = DEPTH * I_L;
    auto item_of = [&](int it) -> P0Item {
        const int l = it / I_L; int r = it % I_L;
        if (r < I_IN) return p0_item(I.w_in + (size_t)l * DM * INC, DM, INC, I.win_t + (size_t)l * INC * DM, r, true, nullptr);
        r -= I_IN;
        if (r < I_OUT) return p0_item(I.w_out + (size_t)l * DM * DM, DM, DM, I.wout_t + (size_t)l * DM * DM, r, false, I.gna + (size_t)l * NAW);
        r -= I_OUT;
        if (r < I_1) return p0_item(I.w1 + (size_t)l * DM * DFF, DM, DFF, I.w1_t + (size_t)l * DFF * DM, r, false, nullptr);
        r -= I_1;
        return p0_item(I.w2 + (size_t)l * DFF * DM, DFF, DM, I.w2_t + (size_t)l * DM * DFF, r, false, nullptr); };
    float wa[32], wb[32];
    P0Item d0 = item_of(min(gw, NITEMS - 1));
    p0_load(wa, d0, F.lane);
#pragma unroll 1
    for (int it = gw; it < NITEMS; it += 2 * NGW) {
        const int i1 = it + NGW, i2 = it + 2 * NGW;
        const P0Item d1 = item_of(min(i1, NITEMS - 1));
        p0_load(wb, d1, F.lane);
        p0_process(wa, d0, scr, F.lane);
        const P0Item d2 = item_of(min(i2, NITEMS - 1));
        p0_load(wa, d2, F.lane);
        if (i1 < NITEMS) p0_process(wb, d1, scr, F.lane);
        d0 = d2;
    }
}

__device__ __forceinline__ void norm_prep_phase(Frame& F, const float* src_lat, const float* src_ctx, const bf16* src_ctx_bf, const float* g, const float* sc_base, bf16* A2, float* ssq, int row_lo, int nrows,
                                                const float* part, const float* gate_ctx, bf16* ctx_out, const float* ssqh) {
    const int gw = F.vcu * NWAVES + F.wave, NGW = F.G * NWAVES;
    for (int row = row_lo + gw; row < nrows; row += NGW) {
        const bool lat = row < MLAT;
        const float* sc = sc_base + (size_t)(lat ? (row >> 13) : 4) * MODW;
        f32x4v v[8]; float ss = 0.f;
        if (lat || src_ctx) { const float* xr = lat ? src_lat + (size_t)row * DM : src_ctx + (size_t)(row - MLAT) * DM;
#pragma unroll
            for (int j = 0; j < 8; ++j) v[j] = *(const f32x4v*)(xr + 256 * j + 4 * F.lane); }
        else { const bf16* xb = src_ctx_bf + (size_t)(row - MLAT) * DM;
#pragma unroll
            for (int j = 0; j < 8; ++j) { const u32x2 r = *(const u32x2*)(xb + 256 * j + 4 * F.lane); v[j] = (f32x4v){bf_lo(r.x), bf_hi(r.x), bf_lo(r.y), bf_hi(r.y)}; } }
        if (!lat && part) {
            const float* pr = part + (size_t)(row - MLAT) * DM + 4 * F.lane;
            float na_scale = 1.0f;
            if (ssqh) { const float* sp = ssqh + (size_t)(row - MLAT) * NH; float t = 0.f;
#pragma unroll
                for (int hh = 0; hh < NH; ++hh) t += sp[hh];
                na_scale = rsqrtf(t * (1.0f / NAW) + EPS); }
#pragma unroll
            for (int j = 0; j < 8; ++j) { f32x4v a = *(const f32x4v*)(pr + 256 * j);
#pragma unroll
                for (int s = 1; s < NSPLIT / 2; ++s) a += *(const f32x4v*)(pr + (size_t)s * MCTX * DM + 256 * j);
                a = a * na_scale;
#pragma unroll
                for (int s = NSPLIT / 2; s < NSPLIT; ++s) a += *(const f32x4v*)(pr + (size_t)s * MCTX * DM + 256 * j);
                v[j] += *(const f32x4v*)(gate_ctx + 256 * j + 4 * F.lane) * a;
                { u32x2 o; o.x = pk2(v[j].x, v[j].y); o.y = pk2(v[j].z, v[j].w); *(u32x2*)(ctx_out + (size_t)(row - MLAT) * DM + 256 * j + 4 * F.lane) = o; } }
        }
#pragma unroll
        for (int j = 0; j < 8; ++j) { ss += (v[j].x * v[j].x + v[j].y * v[j].y) + (v[j].z * v[j].z + v[j].w * v[j].w);
            const int c = 256 * j + 4 * F.lane;
            const f32x4v y = v[j] * (*(const f32x4v*)(g + c)) * (*(const f32x4v*)(sc + c) + 1.0f);
            u32x2 o; o.x = pk2(y.x, y.y); o.y = pk2(y.z, y.w);
            *(u32x2*)(A2 + (size_t)row * DM + c) = o; }
        ss = wave_sum(ss);
        if (F.lane == 0) ssq[row] = rsqrtf(ss * (1.0f / DM) + EPS);
    }
}
__device__ __forceinline__ void norm_prep0_phase(Frame& F, const float* src_lat, const float* src_ctx, const float* g, const float* sc_base, bf16* A2, float* ssq) {
    const int gw = F.vcu * NWAVES + F.wave, NGW = F.G * NWAVES;
    for (int row = gw; row < MT; row += 2 * NGW) {
        const int rowb = row + NGW; const bool has1 = rowb < MT; const int row1 = has1 ? rowb : row;
        const float* x0 = row < MLAT ? src_lat + (size_t)row * DM : src_ctx + (size_t)(row - MLAT) * DM;
        const float* x1 = row1 < MLAT ? src_lat + (size_t)row1 * DM : src_ctx + (size_t)(row1 - MLAT) * DM;
        f32x4v v0[8], v1[8];
#pragma unroll
        for (int j = 0; j < 8; ++j) v0[j] = *(const f32x4v*)(x0 + 256 * j + 4 * F.lane);
#pragma unroll
        for (int j = 0; j < 8; ++j) v1[j] = *(const f32x4v*)(x1 + 256 * j + 4 * F.lane);
        const float* sc0 = sc_base + (size_t)(row < MLAT ? (row >> 13) : 4) * MODW; const float* sc1 = sc_base + (size_t)(row1 < MLAT ? (row1 >> 13) : 4) * MODW;
        float s0 = 0.f, s1 = 0.f;
#pragma unroll
        for (int j = 0; j < 8; ++j) { const int c = 256 * j + 4 * F.lane; const f32x4v gg = *(const f32x4v*)(g + c);
            s0 += (v0[j].x * v0[j].x + v0[j].y * v0[j].y) + (v0[j].z * v0[j].z + v0[j].w * v0[j].w);
            s1 += (v1[j].x * v1[j].x + v1[j].y * v1[j].y) + (v1[j].z * v1[j].z + v1[j].w * v1[j].w);
            const f32x4v y0 = v0[j] * gg * (*(const f32x4v*)(sc0 + c) + 1.0f), y1 = v1[j] * gg * (*(const f32x4v*)(sc1 + c) + 1.0f);
            u32x2 o0, o1; o0.x = pk2(y0.x, y0.y); o0.y = pk2(y0.z, y0.w); o1.x = pk2(y1.x, y1.y); o1.y = pk2(y1.z, y1.w);
            *(u32x2*)(A2 + (size_t)row * DM + c) = o0;
            if (has1) *(u32x2*)(A2 + (size_t)row1 * DM + c) = o1; }
        s0 = wave_sum(s0); s1 = wave_sum(s1);
        if (F.lane == 0) { ssq[row] = rsqrtf(s0 * (1.0f / DM) + EPS); if (has1) ssq[row1] = rsqrtf(s1 * (1.0f / DM) + EPS); }
    }
}
__device__ __forceinline__ void ctx_norm_phase(Frame& F, const float* src_ctx, const bf16* src_ctx_bf, const float* g, const float* sc_base, bf16* A2, float* ssq,
                                               const float* part, const float* gate_ctx, bf16* ctx_out, const float* ssqh) {
    LAS float* red = (LAS float*)(F.lds + RING_OFF);
    const float* sc = sc_base + (size_t)4 * MODW;
    const int hf = F.wave >> 2, cb = 1024 * hf + 4 * F.lane;
    __syncthreads();
    for (int rr = F.vcu * 4 + (F.wave & 3); rr < MCTX; rr += 4 * F.G) {
        const int row = MLAT + rr;
        f32x4v v[4];
        if (src_ctx) {
#pragma unroll
            for (int j = 0; j < 4; ++j) v[j] = *(const f32x4v*)(src_ctx + (size_t)rr * DM + cb + 256 * j); }
        else {
#pragma unroll
            for (int j = 0; j < 4; ++j) { const u32x2 r = *(const u32x2*)(src_ctx_bf + (size_t)rr * DM + cb + 256 * j); v[j] = (f32x4v){bf_lo(r.x), bf_hi(r.x), bf_lo(r.y), bf_hi(r.y)}; } }
        float na_scale = 1.0f;
        if (ssqh) { const float* sp = ssqh + (size_t)rr * NH; float t = 0.f;
#pragma unroll
            for (int hh = 0; hh < NH; ++hh) t += sp[hh];
            na_scale = rsqrtf(t * (1.0f / NAW) + EPS); }
        const float* pr = part + (size_t)rr * DM + cb;
        float ss = 0.f;
        f32x4v pa[2][NSPLIT];
#pragma unroll
        for (int j = 0; j < 4; ++j) {
            if ((j & 1) == 0) {
#pragma unroll
                for (int jj = 0; jj < 2; ++jj)
#pragma unroll
                    for (int s = 0; s < NSPLIT; ++s) pa[jj][s] = *(const f32x4v*)(pr + (size_t)s * MCTX * DM + 256 * (j + jj));
                asm volatile("" ::: "memory"); }
            f32x4v a = pa[j & 1][0];
#pragma unroll
            for (int s = 1; s < NSPLIT / 2; ++s) a += pa[j & 1][s];
            a = a * na_scale;
#pragma unroll
            for (int s = NSPLIT / 2; s < NSPLIT; ++s) a += pa[j & 1][s];
            const int c = cb + 256 * j;
            v[j] += *(const f32x4v*)(gate_ctx + c) * a;
            { u32x2 o; o.x = pk2(v[j].x, v[j].y); o.y = pk2(v[j].z, v[j].w); *(u32x2*)(ctx_out + (size_t)rr * DM + c) = o; }
            ss += (v[j].x * v[j].x + v[j].y * v[j].y) + (v[j].z * v[j].z + v[j].w * v[j].w);
            const f32x4v y = v[j] * (*(const f32x4v*)(g + c)) * (*(const f32x4v*)(sc + c) + 1.0f);
            u32x2 o; o.x = pk2(y.x, y.y); o.y = pk2(y.z, y.w);
            *(u32x2*)(A2 + (size_t)row * DM + c) = o; }
        ss = wave_sum(ss);
        if (F.lane == 0) red[F.wave] = ss;
        __syncthreads();
        if (hf == 0 && F.lane == 0) ssq[row] = rsqrtf((red[F.wave] + red[F.wave + 4]) * (1.0f / DM) + EPS);
        __syncthreads();
    }
}
__device__ __forceinline__ void ssq_reduce_phase(Frame& F, const float* ssqp, float* ssq, int nrows) {
    const int gt = F.vcu * (NWAVES * 64) + F.tid, NGT = F.G * NWAVES * 64;
    for (int it = gt; it < 4 * nrows; it += NGT) { const int row = it >> 2, q = it & 3; float s = 0.f;
#pragma unroll
        for (int k = 0; k < 8; ++k) s += ssqp[(size_t)(8 * q + k) * MT + row];
        s += dpp_mov<0xB1>(s); s += dpp_mov<0x4E>(s);
        if (q == 0) ssq[row] = rsqrtf(s * (1.0f / DM) + EPS); }
}
__device__ __forceinline__ void shw_phase(Frame& F, const bf16* WT, const float* sh_base, float* shw, int N, int cu_rank, int n_cus) {
    LAS float* SH = (LAS float*)(F.lds + RING_OFF);
    __syncthreads();
    for (int i = F.tid; i < 5 * DM; i += NWAVES * 64) SH[i] = sh_base[(size_t)(i / DM) * MODW + (i % DM)];
    __syncthreads();
    const int gw = cu_rank * NWAVES + F.wave, NGW = n_cus * NWAVES;
    for (int n = gw; n < N; n += NGW) {
        float w[4][8];
#pragma unroll
        for (int j = 0; j < 4; ++j) { const v4u wv = *(const GAS v4u*)(WT + (size_t)n * DM + 512 * j + 8 * F.lane);
            w[j][0] = bf_lo(wv.x); w[j][1] = bf_hi(wv.x); w[j][2] = bf_lo(wv.y); w[j][3] = bf_hi(wv.y); w[j][4] = bf_lo(wv.z); w[j][5] = bf_hi(wv.z); w[j][6] = bf_lo(wv.w); w[j][7] = bf_hi(wv.w); }
        float d[5];
#pragma unroll
        for (int r = 0; r < 5; ++r) { d[r] = 0.f;
#pragma unroll
            for (int j = 0; j < 4; ++j) { const f32x4v s0 = *(const LAS f32x4v*)(SH + r * DM + 512 * j + 8 * F.lane), s1 = *(const LAS f32x4v*)(SH + r * DM + 512 * j + 8 * F.lane + 4);
                d[r] += (w[j][0] * s0.x + w[j][1] * s0.y) + (w[j][2] * s0.z + w[j][3] * s0.w) + (w[j][4] * s1.x + w[j][5] * s1.y) + (w[j][6] * s1.z + w[j][7] * s1.w); } }
#pragma unroll
        for (int r = 0; r < 5; ++r) d[r] = wave_sum(d[r]);
        if (F.lane == 0) {
#pragma unroll
            for (int r = 0; r < 5; ++r) shw[(size_t)r * N + n] = d[r]; }
    }
}
__device__ __forceinline__ void final_norm_phase(Frame& F, const bf16* X, const float* g, float* out) {
    const int gw = F.vcu * NWAVES + F.wave, NGW = F.G * NWAVES;
    f32x4v gg[8];
#pragma unroll
    for (int j = 0; j < 8; ++j) gg[j] = *(const f32x4v*)(g + 256 * j + 4 * F.lane);
    for (int row = gw; row < MLAT; row += 2 * NGW) {
        const int row1 = row + NGW; const bool has1 = row1 < MLAT;
        const bf16* xr0 = X + (size_t)row * DM; const bf16* xr1 = X + (size_t)(has1 ? row1 : row) * DM;
        u32x2 r0[8], r1[8];
#pragma unroll
        for (int j = 0; j < 8; ++j) r0[j] = *(const u32x2*)(xr0 + 256 * j + 4 * F.lane);
#pragma unroll
        for (int j = 0; j < 8; ++j) r1[j] = *(const u32x2*)(xr1 + 256 * j + 4 * F.lane);
        f32x4v v0[8], v1[8]; float s0 = 0.f, s1 = 0.f;
#pragma unroll
        for (int j = 0; j < 8; ++j) { v0[j] = (f32x4v){bf_lo(r0[j].x), bf_hi(r0[j].x), bf_lo(r0[j].y), bf_hi(r0[j].y)};
            s0 += (v0[j].x * v0[j].x + v0[j].y * v0[j].y) + (v0[j].z * v0[j].z + v0[j].w * v0[j].w); }
#pragma unroll
        for (int j = 0; j < 8; ++j) { v1[j] = (f32x4v){bf_lo(r1[j].x), bf_hi(r1[j].x), bf_lo(r1[j].y), bf_hi(r1[j].y)};
            s1 += (v1[j].x * v1[j].x + v1[j].y * v1[j].y) + (v1[j].z * v1[j].z + v1[j].w * v1[j].w); }
        const float rstd0 = rsqrtf(wave_sum(s0) * (1.0f / DM) + EPS), rstd1 = rsqrtf(wave_sum(s1) * (1.0f / DM) + EPS);
#pragma unroll
        for (int j = 0; j < 8; ++j) *(f32x4v*)(out + (size_t)row * DM + 256 * j + 4 * F.lane) = (v0[j] * rstd0) * gg[j];
        if (has1) {
#pragma unroll
            for (int j = 0; j < 8; ++j) *(f32x4v*)(out + (size_t)row1 * DM + 256 * j + 4 * F.lane) = (v1[j] * rstd1) * gg[j]; }
    }
}

namespace mix {
constexpr int KSTR = 272, VSTR = 288;
constexpr int KBUF = 64 * KSTR, VBUF = 64 * VSTR, CHB = KBUF + VBUF;
constexpr int BIAS_OFF = 2 * CHB;
constexpr int CW_OFF = BIAS_OFF + NH * RPB_HS * 4, GCV_OFF = CW_OFF + 3 * CVW * 4;
constexpr int MIX_LDS = GCV_OFF + CVW * 4;
static_assert(CW_OFF % 16 == 0, "LDS alignment");
typedef float f32x2_t __attribute__((ext_vector_type(2))); typedef __bf16 bf16x2_t __attribute__((ext_vector_type(2)));
__device__ __forceinline__ unsigned cvtpk(float lo, float hi) { f32x2_t v = {lo, hi}; bf16x2_t b = __builtin_convertvector(v, bf16x2_t); return __builtin_bit_cast(unsigned, b); }
static_assert(MIX_LDS <= RING_BYTES, "mixer LDS");
constexpr float LOG2E = 1.4426950408889634f;
constexpr float SC2 = 0.08838834764831845f * LOG2E;
constexpr float NEG = -1.0e30f;

struct ChunkRegs { v4u k0, k1, v0, v1; };
__device__ __forceinline__ void chunk_load(ChunkRegs& R, const bf16* P, int tid, int h, int ci, int nloc, int a_lo, int lat0, int ctx0) {
    const int krow0 = ci < nloc ? lat0 + (a_lo + ci) * GRID_W : ctx0 + (ci - nloc) * 64;
    const int key = tid >> 4, c16 = tid & 15;
    const bf16* p0 = P + (size_t)(krow0 + key) * PPITCH + h * HD + 8 * c16;
    const bf16* p1 = p0 + (size_t)32 * PPITCH;
    R.k0 = *(const GAS v4u*)(p0 + COL_K); R.k1 = *(const GAS v4u*)(p1 + COL_K);
    R.v0 = *(const GAS v4u*)(p0 + COL_V); R.v1 = *(const GAS v4u*)(p1 + COL_V);
}
__device__ __forceinline__ void chunk_store(const ChunkRegs& R, LAS unsigned char* buf, int tid) {
    const int key = tid >> 4, c16 = tid & 15;
    *(LAS v4u*)(buf + key * KSTR + 16 * c16) = R.k0; *(LAS v4u*)(buf + (key + 32) * KSTR + 16 * c16) = R.k1;
    *(LAS v4u*)(buf + KBUF + key * VSTR + 16 * c16) = R.v0; *(LAS v4u*)(buf + KBUF + (key + 32) * VSTR + 16 * c16) = R.v1;
}

template <unsigned NEED, bool LOC, class LD>
__device__ __forceinline__ void chunk_compute(const LAS unsigned char* Kb, const LAS unsigned char* Vb, bf16x8 (&qf)[4], f32x4v (&O)[8], float& m_run, float& l_run,
                                              const LAS float* bt, int qi, int g, int d0, int v0, const bf16* qnext, const LD& issue_prefetch) {
    f32x4v sa[4];
#pragma unroll
    for (int kt = 0; kt < 4; ++kt) sa[kt] = (f32x4v){0.f, 0.f, 0.f, 0.f};
    const LAS unsigned char* kp = Kb + qi * KSTR + 16 * g;
    bf16x8 kfr[2][4];
#define MIX_KREAD(set, ks_) do { _Pragma("unroll") for (int kt = 0; kt < 4; ++kt) if ((NEED >> kt) & 1u) kfr[set][kt] = *(const LAS bf16x8*)(kp + 16 * kt * KSTR + 64 * (ks_)); } while (0)
    MIX_KREAD(0, 0);
#pragma unroll
    for (int ks = 0; ks < 4; ++ks) {
        if (ks + 1 < 4) { if (((ks + 1) & 1) == 0) MIX_KREAD(0, ks + 1); else MIX_KREAD(1, ks + 1); }
        __builtin_amdgcn_sched_barrier(0);
#pragma unroll
        for (int kt = 0; kt < 4; ++kt)
            if ((NEED >> kt) & 1u) sa[kt] = __builtin_amdgcn_mfma_f32_16x16x32_bf16(kfr[ks & 1][kt], qf[ks], sa[kt], 0, 0, 0);
        __builtin_amdgcn_sched_barrier(0);
    }
#undef MIX_KREAD
    constexpr bool NP0 = (NEED & 3u) != 0u, NP1 = (NEED & 0xCu) != 0u; constexpr int NG = 2 * ((NP0 ? 1 : 0) + (NP1 ? 1 : 0));
#define MIX_PPOF(gi) (NP0 ? ((gi) >> 1) : 1)
    const LAS unsigned char* vbase = Vb + (4 * g + (qi >> 2)) * VSTR + 8 * (qi & 3);
    v4i16_t va[2][8];
#define MIX_VREAD(set, gi) do { _Pragma("unroll") for (int d4 = 0; d4 < 4; ++d4) { const int dt_ = 4 * ((gi) & 1) + d4; \
        va[set][d4] = __builtin_amdgcn_ds_read_tr16_b64_v4i16((LAS v4i16_t*)(vbase + 32 * MIX_PPOF(gi) * VSTR + 32 * dt_)); \
        va[set][4 + d4] = __builtin_amdgcn_ds_read_tr16_b64_v4i16((LAS v4i16_t*)(vbase + (32 * MIX_PPOF(gi) + 16) * VSTR + 32 * dt_)); } } while (0)
    MIX_VREAD(0, 0);
    issue_prefetch();
    if (!LOC) {
#pragma unroll
        for (int ks = 0; ks < 4; ++ks) qf[ks] = *(const GAS bf16x8*)(qnext + 32 * ks); }
    float s[4][4];
    if (LOC) {
        float bv[4][4];
#pragma unroll
        for (int kt = 0; kt < 4; ++kt)
            if ((NEED >> kt) & 1u) {
#pragma unroll
                for (int e = 0; e < 4; ++e) { const int dcol = d0 + 16 * kt + e; bv[kt][e] = bt[min(max(dcol, 0), RPB_C - 1)]; asm volatile("" : "+v"(bv[kt][e])); } }
#pragma unroll
        for (int kt = 0; kt < 4; ++kt)
#pragma unroll
            for (int e = 0; e < 4; ++e) {
                if ((NEED >> kt) & 1u) { const bool valid = (unsigned)(v0 + 16 * kt + e) < (unsigned)WIN_C; s[kt][e] = valid ? sa[kt][e] * SC2 + bv[kt][e] : NEG; }
                else s[kt][e] = NEG; }
    } else {
#pragma unroll
        for (int kt = 0; kt < 4; ++kt)
#pragma unroll
            for (int e = 0; e < 4; ++e) s[kt][e] = ((NEED >> kt) & 1u) ? sa[kt][e] * SC2 : NEG;
    }
    float mx = NEG;
#pragma unroll
    for (int kt = 0; kt < 4; ++kt)
        if ((NEED >> kt) & 1u) {
#pragma unroll
            for (int e = 0; e < 4; ++e) mx = fmaxf(mx, s[kt][e]); }
    mx = x32_max(x16_max(mx));
    const float m_new = fmaxf(m_run, mx);
    {
        const float alpha = __builtin_amdgcn_exp2f(m_run - m_new);
        l_run *= alpha;
#pragma unroll
        for (int dt = 0; dt < 8; ++dt) O[dt] = O[dt] * alpha;
    }
    m_run = m_new;
    float psum = 0.f; unsigned pk[4][2];
#pragma unroll
    for (int kt = 0; kt < 4; ++kt) {
        if ((NEED >> kt) & 1u) { float p[4];
#pragma unroll
            for (int e = 0; e < 4; ++e) { p[e] = __builtin_amdgcn_exp2f(s[kt][e] - m_new); psum += p[e]; }
            pk[kt][0] = cvtpk(p[0], p[1]); pk[kt][1] = cvtpk(p[2], p[3]); }
        else { pk[kt][0] = 0u; pk[kt][1] = 0u; } }
    l_run += psum;
    bf16x8 pf[2];
#pragma unroll
    for (int pp = 0; pp < 2; ++pp) { const v4u pw = (v4u){pk[2 * pp][0], pk[2 * pp][1], pk[2 * pp + 1][0], pk[2 * pp + 1][1]}; pf[pp] = __builtin_bit_cast(bf16x8, pw); }
#pragma unroll
    for (int gi = 0; gi < NG; ++gi) {
        if (gi + 1 < NG) { if (((gi + 1) & 1) == 0) MIX_VREAD(0, gi + 1); else MIX_VREAD(1, gi + 1); }
#pragma unroll
        for (int d4 = 0; d4 < 4; ++d4) { const int dt = 4 * (gi & 1) + d4; const v4i16_t lo = va[gi & 1][d4], hi = va[gi & 1][4 + d4];
            const bf16x8 vf = (bf16x8){lo[0], lo[1], lo[2], lo[3], hi[0], hi[1], hi[2], hi[3]};
            O[dt] = __builtin_amdgcn_mfma_f32_16x16x32_bf16(vf, pf[MIX_PPOF(gi)], O[dt], 0, 0, 0); }
    }
#undef MIX_VREAD
#undef MIX_PPOF
}

__device__ __forceinline__ void mixer_unit(Frame& F, int u, const bf16* P, bf16* MIXO, const float* conv_w, const float* g_na, const float* g_cv, float* ssqh, bool bal, float* rna) {
    LAS unsigned char* L = F.lds + RING_OFF;
    const LAS float* btab = (const LAS float*)(L + BIAS_OFF);
    const int w = F.wave;
    const bool lat = u < 256;
    int b, tok0, nloc, a_lo, r0, seq_lo, seq_hi;
    if (lat) { b = u >> 6; r0 = 2 * (u & 63); tok0 = b * SEQ + r0 * GRID_W; a_lo = min(max(r0 - 4, 0), GRID_R - WIN_R); const int a_hi = min(max(r0 + 1 - 4, 0), GRID_R - WIN_R) + WIN_R - 1; nloc = a_hi - a_lo + 1;
               seq_lo = b * SEQ; seq_hi = seq_lo + SEQ; }
    else { const int v = u - 256; b = v >> 4; r0 = 0; tok0 = MLAT + b * CTXL + 128 * ((v >> 3) & 1); a_lo = 0; nloc = 0; seq_lo = MLAT + b * CTXL; seq_hi = seq_lo + CTXL; }
    const int h_lo = lat ? 0 : ((u - 256) & 7), h_hi = lat ? NH : h_lo + 1;
    const int lat0 = b * SEQ, ctx0 = MLAT + b * CTXL;
    const int nch = nloc + 4;
    const int rw = r0 + (w >> 2), qt = (w & 3) ^ (w >> 2);
    const int tw = 64 * (w >> 2) + 16 * qt;
    const int rs_w = min(max(rw - 4, 0), GRID_R - WIN_R);
    const int kb0 = qt == 0 ? 0 : qt == 1 ? 8 : qt == 2 ? 24 : 32;

    const bool conv_first = (F.vcu & 1) != 0;
#pragma unroll 1
    for (int pass = 0; pass < 2; ++pass) {
    if ((pass == 0) != conv_first) {
    int tid_a = threadIdx.x; asm volatile("" : "+v"(tid_a));
    const int tid = tid_a, lane_a = tid_a & 63, qi = lane_a & 15, g = lane_a >> 4;
    const int cq = 16 * qt + qi;
    const int cs = min(max(cq - 8, 0), GRID_W - WIN_C);
    const int d0 = 4 * g - cq + (WIN_C - 1), v0 = 4 * g - cs;
    const int qrow = tok0 + tw + qi;
    ChunkRegs CR;
    bf16x8 qf[4];
#pragma unroll
    for (int ks = 0; ks < 4; ++ks) qf[ks] = *(const GAS bf16x8*)(P + (size_t)qrow * PPITCH + COL_Q + h_lo * HD + 32 * ks + 8 * g);
    const int total = (h_hi - h_lo) * nch;
    chunk_load(CR, P, tid, h_lo, 0, nloc, a_lo, lat0, ctx0);
    chunk_store(CR, L, tid);
    __syncthreads();

    float ssq = 0.f;
    f32x4v O[8]; float m_run = NEG, l_run = 0.f;
#pragma unroll
    for (int dt = 0; dt < 8; ++dt) O[dt] = (f32x4v){0.f, 0.f, 0.f, 0.f};
    int h = h_lo, ci = 0;
    int h2 = h_lo, c2 = 1;
#define MIX_STEP(BUF, S_) do { \
        const bool lastc = ci == nch - 1; \
        auto pre = [&]() { chunk_load(CR, P, tid, min(h2, h_hi - 1), c2, nloc, a_lo, lat0, ctx0); };     \
        const LAS unsigned char* Kb = L + (BUF) * CHB; const LAS unsigned char* Vb = Kb + KBUF; \
        if (ci < nloc) { const int a = a_lo + ci; \
            if (a >= rs_w && a < rs_w + WIN_R) { const LAS float* bt = btab + h * RPB_HS + (a - rw + WIN_R - 1) * RPB_C; \
                chunk_compute<0x3u, true>(Kb + kb0 * KSTR, Vb + kb0 * VSTR, qf, O, m_run, l_run, bt, qi, g, d0 + kb0, v0 + kb0, (const bf16*)nullptr, pre); }     \
            else pre(); \
        } else chunk_compute<0xFu, false>(Kb, Vb, qf, O, m_run, l_run, btab, qi, g, d0, v0, P + (size_t)qrow * PPITCH + COL_Q + ((lastc && h < h_hi - 1) ? h + 1 : h) * HD + 8 * g, pre); \
        chunk_store(CR, L + (1 - (BUF)) * CHB, tid);     \
        if (lastc) { float lt = x32_sum(x16_sum(l_run)); const float inv = 1.0f / lt; \
            bf16* op = MIXO + (size_t)qrow * DM + h * HD + 4 * g; \
            _Pragma("unroll") for (int dt = 0; dt < 8; ++dt) { f32x4v o = O[dt] * inv; ssq += (o.x * o.x + o.y * o.y) + (o.z * o.z + o.w * o.w); \
                u32x2 ov; ov.x = cvtpk(o.x, o.y); ov.y = cvtpk(o.z, o.w); *(GAS u32x2*)(op + 16 * dt) = ov; O[dt] = (f32x4v){0.f, 0.f, 0.f, 0.f}; } \
            m_run = NEG; l_run = 0.f; } \
        LDS_WAIT(); __builtin_amdgcn_s_barrier(); asm volatile("" ::: "memory"); __builtin_amdgcn_s_barrier(); asm volatile("" ::: "memory"); __builtin_amdgcn_s_barrier(); asm volatile("" ::: "memory");     \
        if (++ci == nch) { ci = 0; ++h; } if (++c2 == nch) { c2 = 0; ++h2; } \
    } while (0)
    for (int s = 0; s < total; s += 2) { MIX_STEP(0, s); MIX_STEP(1, s + 1); }
#undef MIX_STEP
    ssq = x32_sum(x16_sum(ssq));
    const float rstd = rsqrtf(ssq * (1.0f / NAW) + EPS);
    if (!lat && g == 0) ssqh[(size_t)(qrow - MLAT) * NH + h_lo] = ssq;
    if (lat && (lane_a >> 4) == 0) rna[tok0 + tw + qi] = rstd;
    } else {
    {
        int lane_c = F.lane; asm volatile("" : "+v"(lane_c)); const int lane = lane_c;
        const LAS float* cwl = (const LAS float*)(L + CW_OFF) + 8 * lane; const LAS float* gcl = (const LAS float*)(L + GCV_OFF) + 8 * lane;
        struct CvSet { v4u c[2], b[2]; };
        float cu[3][2][8];
#define CV_PROD(dst, A_) do { _Pragma("unroll") for (int j = 0; j < 2; ++j) { const v4u a_ = (A_)[j]; \
            dst[j][0] = bf_lo(a_.x); dst[j][1] = bf_hi(a_.x); dst[j][2] = bf_lo(a_.y); dst[j][3] = bf_hi(a_.y); \
            dst[j][4] = bf_lo(a_.z); dst[j][5] = bf_hi(a_.z); dst[j][6] = bf_lo(a_.w); dst[j][7] = bf_hi(a_.w); } } while (0)
#define CV_LOADROW(CC, row) do { const bool ok_ = (row) >= seq_lo && (row) < seq_hi; _Pragma("unroll") for (int j = 0; j < 2; ++j) { (CC)[j] = (v4u){0u, 0u, 0u, 0u}; \
            if (ok_) (CC)[j] = *(const GAS v4u*)(P + (size_t)(row) * PPITCH + COL_CG + 8 * lane + 512 * j); } } while (0)
#define CV_ISSUE(S, tt) do { CV_LOADROW((S).c, (tt) + 1); _Pragma("unroll") for (int j = 0; j < 2; ++j) (S).b[j] = *(const GAS v4u*)(P + (size_t)(tt) * PPITCH + COL_BG + 8 * lane + 512 * j); } while (0)
#define CV_TOKEN(S, tt, more) do { \
            CV_PROD(cu[2], (S).c); const v4u bg0_ = (S).b[0], bg1_ = (S).b[1]; \
            if (more) CV_ISSUE(S, (tt) + 1); \
            float o[2][8]; float ss = 0.f; \
            _Pragma("unroll") for (int j = 0; j < 2; ++j) { const v4u bgv = j ? bg1_ : bg0_; \
                const float bgf[8] = {bf_lo(bgv.x), bf_hi(bgv.x), bf_lo(bgv.y), bf_hi(bgv.y), bf_lo(bgv.z), bf_hi(bgv.z), bf_lo(bgv.w), bf_hi(bgv.w)}; \
                _Pragma("unroll") for (int e4 = 0; e4 < 2; ++e4) { const f32x4v w0 = *(const LAS f32x4v*)(cwl + 512 * j + 4 * e4), w1 = *(const LAS f32x4v*)(cwl + CVW + 512 * j + 4 * e4), w2 = *(const LAS f32x4v*)(cwl + 2 * CVW + 512 * j + 4 * e4); \
                    _Pragma("unroll") for (int e = 0; e < 4; ++e) { const int ee = 4 * e4 + e; const float cvv = w0[e] * cu[0][j][ee] + w1[e] * cu[1][j][ee] + w2[e] * cu[2][j][ee]; o[j][ee] = bgf[ee] * cvv; ss += o[j][ee] * o[j][ee]; } } } \
            const float rs = rsqrtf(wave_sum(ss) * (1.0f / CVW) + EPS); \
            _Pragma("unroll") for (int j = 0; j < 2; ++j) { const f32x4v g0 = *(const LAS f32x4v*)(gcl + 512 * j), g1 = *(const LAS f32x4v*)(gcl + 512 * j + 4); v4u ov; \
                ov.x = cvtpk(o[j][0] * rs * g0.x, o[j][1] * rs * g0.y); ov.y = cvtpk(o[j][2] * rs * g0.z, o[j][3] * rs * g0.w); \
                ov.z = cvtpk(o[j][4] * rs * g1.x, o[j][5] * rs * g1.y); ov.w = cvtpk(o[j][6] * rs * g1.z, o[j][7] * rs * g1.w); \
                *(GAS v4u*)(MIXO + (size_t)(tt) * DM + NAW + 8 * lane + 512 * j) = ov; } \
            _Pragma("unroll") for (int j = 0; j < 2; ++j) _Pragma("unroll") for (int e = 0; e < 8; ++e) { cu[0][j][e] = cu[1][j][e]; cu[1][j][e] = cu[2][j][e]; } \
        } while (0)
        CvSet SA;
        const int gm = u & 3;
        const int nseg = (lat && bal && gm != 3) ? 2 : 1;
#pragma unroll 1
        for (int seg = 0; seg < nseg; ++seg) {
        const int ntok = !lat ? 2 : (seg == 1 ? 2 : ((bal && gm == 3) ? 10 : 16));
        const int tc0 = !lat ? tok0 + 16 * h_lo + 2 * w : (seg == 1 ? tok0 + (3 - gm) * 128 + 80 + 16 * gm + 2 * w : ((bal && gm == 3) ? tok0 + 10 * w : tok0 + 16 * w));
        { v4u c_[2]; CV_LOADROW(c_, tc0 - 1); CV_PROD(cu[0], c_); CV_LOADROW(c_, tc0); CV_PROD(cu[1], c_); }
        CV_ISSUE(SA, tc0);
#pragma unroll 1
        for (int t = 0; t < ntok; ++t) CV_TOKEN(SA, tc0 + t, t + 1 < ntok);
        }
#undef CV_PROD
#undef CV_LOADROW
#undef CV_ISSUE
#undef CV_TOKEN
    }
    }
    }
}
__device__ __forceinline__ void mixer_phase(Frame& F, const bf16* P, bf16* MIXO, const float* rpb_l, const float* conv_w, const float* g_na, const float* g_cv, int n_units, float* ssqh, float* rna) {
    LAS float* btab = (LAS float*)(F.lds + RING_OFF + BIAS_OFF);
    {
        LAS float* cwl = (LAS float*)(F.lds + RING_OFF + CW_OFF); LAS float* gcl = (LAS float*)(F.lds + RING_OFF + GCV_OFF);
        constexpr int NT = NWAVES * 64, NB_ = (NH * RPB_HS + NT - 1) / NT, NC_ = 3 * CVW / NT, NG_ = CVW / NT;
        static_assert(3 * CVW % NT == 0 && CVW % NT == 0, "table staging");
        float tb[NB_], tc[NC_], tg[NG_];
#pragma unroll
        for (int j = 0; j < NB_; ++j) { const int i = F.tid + NT * j; tb[j] = rpb_l[i < NH * RPB_HS ? i : 0]; }
#pragma unroll
        for (int j = 0; j < NC_; ++j) tc[j] = conv_w[F.tid + NT * j];
#pragma unroll
        for (int j = 0; j < NG_; ++j) tg[j] = g_cv[F.tid + NT * j];
#pragma unroll
        for (int j = 0; j < NB_; ++j) { const int i = F.tid + NT * j; if (i < NH * RPB_HS) btab[i] = tb[j] * LOG2E; }
#pragma unroll
        for (int j = 0; j < NC_; ++j) cwl[F.tid + NT * j] = tc[j];
#pragma unroll
        for (int j = 0; j < NG_; ++j) gcl[F.tid + NT * j] = tg[j];
    }
    __syncthreads();
    const bool bal = n_units > 256 && F.G == 256;
    for (int u = F.vcu; u < n_units && u < 256; u += F.G) mixer_unit(F, u, P, MIXO, conv_w, g_na, g_cv, ssqh, bal, rna);
    if (n_units > 256 && F.G == 256) { if ((F.vcu & 3) == 3) mixer_unit(F, 256 + (F.vcu >> 2), P, MIXO, conv_w, g_na, g_cv, ssqh, false, rna); }
    else for (int u = 256 + F.vcu; u < n_units; u += F.G) mixer_unit(F, u, P, MIXO, conv_w, g_na, g_cv, ssqh, false, rna);
    __syncthreads();
}
}

struct Args { const float* in[17]; float* out; unsigned char* ws; int ph_lo, ph_hi; };
__global__ void __launch_bounds__(NWAVES * 64, 2) skel_fwd(Args args) {
    extern __shared__ __attribute__((aligned(16))) unsigned char lds[];
    Frame F;
    F.lds = (LAS unsigned char*)lds;
    F.MISC = (volatile LAS unsigned*)(F.lds + MISC_OFF);
    F.tid = threadIdx.x; F.lane = F.tid & 63; F.wave = __builtin_amdgcn_readfirstlane(F.tid >> 6);
    F.G = gridDim.x; { const int bx = blockIdx.x; F.vcu = (F.G % 8 == 0) ? (bx % 8) * (F.G / 8) + bx / 8 : bx; }
    unsigned char* ws = args.ws;
    F.ctl = (gu32*)(ws + WS_CTL);
    const float *in_x = args.in[0], *in_ctx = args.in[2];
#define MOD ((float*)(ws + WS_MOD))
#define VEC ((const float*)(ws + WS_VEC))
#define WIN_T ((bf16*)(ws + WS_WIN))
#define WOUT_T ((bf16*)(ws + WS_WOUT))
#define W1_T ((bf16*)(ws + WS_W1))
#define W2_T ((bf16*)(ws + WS_W2))
#define X ((bf16*)(ws + WS_X))
#define XN ((bf16*)(ws + WS_XN))
#define PB ((bf16*)(ws + WS_P))
#define MIXB ((bf16*)(ws + WS_MIX))
#define HB ((bf16*)(ws + WS_H))
#define PO ((float*)(ws + WS_PO))
#define PM ((float*)(ws + WS_PM))
#define SSQ ((float*)(ws + WS_SSQ))
#define SHW ((float*)(ws + WS_SHW))
#define SSQP ((float*)(ws + WS_SSQP))
    for (int u = F.tid; u < (LDS_BYTES - LDSCTL_OFF) / 4; u += NWAVES * 64) ((LAS unsigned*)(F.lds + LDSCTL_OFF))[u] = 0u;
    __syncthreads();
#if MK_PER_PHASE
#define GRID_BAR() do { } while (0)
#else
    XcdBarrier bar = xcd_barrier_post((unsigned*)(F.ctl + CW_BAR), F.MISC + 8);
#define GRID_BAR() xcd_barrier(bar)
#endif
    const int lo = args.ph_lo, hi = args.ph_hi;
#define IN(k) (lo <= (k) && (k) < hi)
#define SEAM(k) do { if (IN((k) + 1)) GRID_BAR(); } while (0)

    if (IN(0)) {
        ProIn I{args.in[1], args.in[3], args.in[4], args.in[5], args.in[7], args.in[12], args.in[14], args.in[15], args.in[6], args.in[13], args.in[8], args.in[9], args.in[10], args.in[11], args.in[16], MOD, (float*)(ws + WS_VEC), WIN_T, WOUT_T, W1_T, W2_T};
        p0_prologue(F, I);
        SEAM(0);
    }
    for (int l = 0; l < DEPTH; ++l) {
        const int pb = 1 + 7 * l;
        const bool last = l == DEPTH - 1;
        const int Mg = last ? MLAT : MT;
        const float* mod_l = MOD + (size_t)l * 5 * MODW;
        const float* vec_l = VEC + (size_t)l * VEC_L;
        bf16* const Xc = X + (size_t)MLAT * DM;
        float* ssq1 = SSQ + (size_t)(2 * l) * MT; float* ssq2 = SSQ + (size_t)(2 * l + 1) * MT;
        float* shw1 = SHW + (size_t)l * 5 * INC; float* shw2 = SHW + (size_t)DEPTH * 5 * INC + (size_t)l * 5 * DFF;
#define OPAQUE_TID() do { int t_ = threadIdx.x; asm volatile("" : "+v"(t_)); F.tid = t_; F.lane = t_ & 63; F.wave = __builtin_amdgcn_readfirstlane(t_ >> 6); } while (0)
        if (IN(pb + 0)) { OPAQUE_TID();
            if (l == 0) norm_prep0_phase(F, in_x, in_ctx, vec_l + VEC_G1, mod_l + 1 * DM, XN, ssq1);
            else { ctx_norm_phase(F, (const float*)nullptr, Xc, vec_l + VEC_G1, mod_l + 1 * DM, XN, ssq1, PM, mod_l - 5 * MODW + 4 * MODW + 5 * DM, Xc, (const float*)nullptr);
                   ssq_reduce_phase(F, SSQP, ssq1, MLAT); }
            if (l == 0) { shw_phase(F, WIN_T, MOD + 0 * DM, SHW, INC, F.vcu, F.G);
                          shw_phase(F, W1_T, MOD + 3 * DM, SHW + (size_t)DEPTH * 5 * INC, DFF, F.vcu, F.G); }
            SEAM(pb + 0); }
        if (IN(pb + 1)) { OPAQUE_TID();
            pg8::Gemm g{XN, WIN_T + (size_t)l * INC * DM, MT, INC, DM}; pg8::CtxColsOrder S;
            S.init(MLAT, INC, F.G, (int)blockIdx.x, DM, MLAT / 256, last ? COL_K / 256 : 0, last ? (COL_BG - COL_K) / 256 : INC / 256);
            pg8::EpiBf16<0, true> E{PB, PPITCH, ssq1, shw1, INC, COL_CG / 256, COL_CG};
            pg8::gemm_phase<pg8::EpiBf16<0, true>, pg8::CtxColsOrder, true, true>(F.lds + RING_OFF, g, S, E, F.tid);
            if (!last) {
                const int nwg_ = (MT / 256) * (INC / 256), rounds_ = (nwg_ + F.G - 1) / F.G, first_idle = nwg_ - (rounds_ - 1) * F.G, c_ = (int)blockIdx.x;
                const bool all_ = first_idle >= F.G;
                if (all_ || c_ >= first_idle) { OPAQUE_TID();
                    const int rank_ = all_ ? F.vcu : c_ - first_idle, ncu_ = all_ ? F.G : F.G - first_idle;
                    shw_phase(F, WIN_T + (size_t)(l + 1) * INC * DM, MOD + (size_t)(l + 1) * 5 * MODW + 0 * DM, SHW + (size_t)(l + 1) * 5 * INC, INC, rank_, ncu_);
                    shw_phase(F, W1_T + (size_t)(l + 1) * DFF * DM, MOD + (size_t)(l + 1) * 5 * MODW + 3 * DM, SHW + (size_t)DEPTH * 5 * INC + (size_t)(l + 1) * 5 * DFF, DFF, rank_, ncu_); } }
            SEAM(pb + 1);
        }
        if (IN(pb + 2)) { OPAQUE_TID();
            mix::mixer_phase(F, PB, MIXB, vec_l + VEC_RPB, vec_l + VEC_CW, vec_l + VEC_GNA, vec_l + VEC_GCV, last ? 256 : 320, (float*)(ws + WS_VEC + 512 * 1024), (float*)(ws + WS_SSQ + 1536 * 1024));
            SEAM(pb + 2);
        }
        if (IN(pb + 3)) { OPAQUE_TID();
            pg8::Gemm g{MIXB, WOUT_T + (size_t)l * DM * DM, Mg, DM, DM}; pg8::CtxSplitOrder S; S.init(MLAT, DM, F.G, (int)blockIdx.x, DM, last ? 0 : NSPLIT, MLAT / 256);
            pg8::EpiGateResSplitMid E{{{l == 0 ? in_x : (const float*)nullptr, X, X, mod_l + 2 * DM, DM, MODW, XN, SSQP, MT, vec_l + VEC_G2, mod_l + 4 * DM}, PO, MLAT / 256, DM}, (const float*)(ws + WS_SSQ + 1536 * 1024)};
            pg8::gemm_phase<pg8::EpiGateResSplitMid, pg8::CtxSplitOrder, true, true>(F.lds + RING_OFF, g, S, E, F.tid);
            SEAM(pb + 3);
        }
        if (IN(pb + 4)) { OPAQUE_TID();
            if (!last) ctx_norm_phase(F, l == 0 ? in_ctx : (const float*)nullptr, Xc, vec_l + VEC_G2, mod_l + 4 * DM, XN, ssq2, PO, mod_l + 4 * MODW + 2 * DM, Xc, (const float*)(ws + WS_VEC + 512 * 1024));
            ssq_reduce_phase(F, SSQP, ssq2, MLAT);
            SEAM(pb + 4); }
        if (IN(pb + 5)) { OPAQUE_TID();
            pg8::Gemm g{XN, W1_T + (size_t)l * DFF * DM, Mg, DFF, DM}; pg8::StaticOrder S; S.init(Mg, DFF, F.G, (int)blockIdx.x, DM);
            pg8::EpiBf16<2> E{HB, DFF, ssq2, shw2, DFF};
            pg8::gemm_phase<pg8::EpiBf16<2>, pg8::StaticOrder, true, true>(F.lds + RING_OFF, g, S, E, F.tid);
            SEAM(pb + 5);
        }
        if (IN(pb + 6)) { OPAQUE_TID();
            pg8::Gemm g{HB, W2_T + (size_t)l * DM * DFF, Mg, DM, DFF}; pg8::CtxSplitOrder S; S.init(MLAT, DM, F.G, (int)blockIdx.x, DFF, last ? 0 : NSPLIT, MLAT / 256);
            pg8::EpiGateResSplit E{{(const float*)nullptr, X, X, mod_l + 5 * DM, DM, MODW, last ? (bf16*)nullptr : XN, SSQP, MT, vec_l + VEC_L + VEC_G1, mod_l + 5 * MODW + 1 * DM}, PM, MLAT / 256, DM};
            pg8::gemm_phase<pg8::EpiGateResSplit, pg8::CtxSplitOrder, true, true>(F.lds + RING_OFF, g, S, E, F.tid);
            SEAM(pb + 6);
        }
    }
    if (IN(N_PHASES - 1)) final_norm_phase(F, X, VEC + VEC_GF, args.out);
#undef IN
#undef SEAM
}

extern "C" void kernel_launch(void* const* d_in, const int* in_sizes, int n_in, void* d_out, int out_size, void* d_ws, size_t ws_size, hipStream_t stream) {
    static int grid = 0;
    if (grid == 0) {
        if (n_in != 17 || in_sizes[0] != MLAT * DM || out_size != MLAT * DM || ws_size < WS_END) { fprintf(stderr, "kernel_launch: shape/workspace mismatch: n_in %d, in0 %d, out %d, ws %zu (need %zu); nothing launched\n", n_in, n_in > 0 ? in_sizes[0] : -1, out_size, ws_size, (size_t)WS_END); grid = -1; return; }
        int dev = 0, cus = 0, per_cu = 0;
        if (hipGetDevice(&dev) != hipSuccess || hipDeviceGetAttribute(&cus, hipDeviceAttributeMultiprocessorCount, dev) != hipSuccess) { fprintf(stderr, "kernel_launch: hipGetDevice / hipDeviceGetAttribute failed; nothing launched\n"); grid = -1; return; }
        if (hipFuncSetAttribute((const void*)skel_fwd, hipFuncAttributeMaxDynamicSharedMemorySize, LDS_BYTES) != hipSuccess) { fprintf(stderr, "kernel_launch: hipFuncSetAttribute failed; nothing launched\n"); grid = -1; return; }
        if (hipOccupancyMaxActiveBlocksPerMultiprocessor(&per_cu, (const void*)skel_fwd, NWAVES * 64, LDS_BYTES) != hipSuccess || per_cu < 1)
            fprintf(stderr, "kernel_launch: note: the occupancy query reports %d workgroups per CU\n", per_cu);
        (void)hipGetLastError();
        grid = cus;
    }
    if (grid < 0) return;
    if (hipMemsetAsync((char*)d_ws + WS_CTL, 0, CTL_ZERO_BYTES, stream) != hipSuccess) { fprintf(stderr, "kernel_launch: hipMemsetAsync of the control words failed; nothing launched\n"); return; }
    Args a{};
    for (int i = 0; i < 17; ++i) a.in[i] = (const float*)d_in[i];
    a.out = (float*)d_out; a.ws = (unsigned char*)d_ws;
#if MK_PER_PHASE
    for (int p = 0; p < N_PHASES; ++p) { a.ph_lo = p; a.ph_hi = p + 1; hipLaunchKernelGGL(skel_fwd, dim3(grid), dim3(NWAVES * 64), LDS_BYTES, stream, a); }
#else
    a.ph_lo = 0; a.ph_hi = N_PHASES;
    hipLaunchKernelGGL(skel_fwd, dim3(grid), dim3(NWAVES * 64), LDS_BYTES, stream, a);
#endif
    const hipError_t le = hipPeekAtLastError();
    if (le != hipSuccess) fprintf(stderr, "kernel_launch: launch failed: %s (grid %d x %d threads, %d B LDS)\n", hipGetErrorName(le), grid, NWAVES * 64, LDS_BYTES);
}
```
